# Optimizing an MI355X kernel written in HIP

```python
import jax, jax.numpy as jnp
from jax import lax
import numpy as np

D_MODEL = 1024
BATCH = 4
SEQ = 4096
DEPTH = 2

HEAD_DIM = 64
N_MIXERS = 4
GROUP_WIDTH = D_MODEL // N_MIXERS
GROUP_HEADS = GROUP_WIDTH // HEAD_DIM
D_MIX = N_MIXERS * GROUP_WIDTH
Q_BLOCK = 128
ROPE_THETA = 500000.0
ROPE_FRACTION = 4
EPS = 1e-6
NEG = -1e30

IDX_HEADS = 4
IDX_DIM = 32
DSA_TOPK = 256

CHUNK = 128

POOL_WINDOWS = (2, 4, 8, 16)
POOL_CH = GROUP_WIDTH // len(POOL_WINDOWS)

KV_DIM = HEAD_DIM
CMP_BLOCK = 32
CMP_STRIDE = 16
SEL_BLOCK = 64
SEL_TOPN = 16
WINDOW = 512

N_EXPERTS = 16
N_EXPERT_GROUPS = 4
EXPERTS_PER_GROUP = N_EXPERTS // N_EXPERT_GROUPS
TOP_K = 2
D_EXPERT = 256

PROJ_SPLITS = (GROUP_WIDTH, GROUP_WIDTH, GROUP_WIDTH, IDX_HEADS * IDX_DIM, IDX_DIM, IDX_HEADS,
               GROUP_WIDTH, GROUP_WIDTH,
               GROUP_WIDTH,
               GROUP_WIDTH, KV_DIM, KV_DIM, KV_DIM, KV_DIM, KV_DIM, KV_DIM, GROUP_HEADS * 3)
IN_WIDTH = sum(PROJ_SPLITS)

kernel_name = 'hybrid_dsa_gmlp_pool_nsa_moe'


def rmsnorm(x, g):
    xf = x.astype(jnp.float32)
    y = xf * lax.rsqrt(jnp.mean(xf * xf, axis=-1, keepdims=True) + EPS)
    return y.astype(x.dtype) * g


def partial_rope(x, pos):
    rd = x.shape[-1] // ROPE_FRACTION
    half = rd // 2
    inv_freq = ROPE_THETA ** (-jnp.arange(half, dtype=jnp.float32) / half)
    ang = pos.astype(jnp.float32)[:, :, None, None] * inv_freq
    cos, sin = jnp.cos(ang), jnp.sin(ang)
    xr = x[..., :rd].astype(jnp.float32)
    x1, x2 = xr[..., :half], xr[..., half:]
    rot = jnp.concatenate([x1 * cos - x2 * sin, x2 * cos + x1 * sin], axis=-1).astype(x.dtype)
    return jnp.concatenate([rot, x[..., rd:]], axis=-1)


def unblock(o):
    o = jnp.moveaxis(o, 0, 1)
    return o.reshape((o.shape[0], o.shape[1] * o.shape[2]) + o.shape[3:])


def gather_rows(table, idx):
    return jax.vmap(lambda t, i: t[i])(table, idx)


def split_projection(z):
    points = np.cumsum(np.array(PROJ_SPLITS))[:-1].tolist()
    return jnp.split(z, points, axis=-1)


def dsa_mixer(q, k, v, iq, ik, iw, pos):
    bsz, seq = q.shape[0], q.shape[1]
    topk = min(DSA_TOPK, seq // 4)
    q = partial_rope(q, pos)
    k = partial_rope(k, pos)
    iq = partial_rope(iq, pos).astype(jnp.float32)
    ik = partial_rope(ik[:, :, None, :], pos)[:, :, 0].astype(jnp.float32)
    iw = iw.astype(jnp.float32)
    key_pos = jnp.arange(seq)
    scale = HEAD_DIM ** -0.5

    def block(i):
        s0 = i * Q_BLOCK
        t_pos = s0 + jnp.arange(Q_BLOCK)
        qb = lax.dynamic_slice_in_dim(q, s0, Q_BLOCK, 1)
        iqb = lax.dynamic_slice_in_dim(iq, s0, Q_BLOCK, 1)
        iwb = lax.dynamic_slice_in_dim(iw, s0, Q_BLOCK, 1)
        idx_logits = jax.nn.relu(jnp.einsum('bthd,bsd->bths', iqb, ik))
        score = jnp.einsum('bth,bths->bts', iwb, idx_logits)
        causal = key_pos[None, :] <= t_pos[:, None]
        score = jnp.where(causal[None], score, -jnp.inf)
        _, sel = lax.top_k(score, topk)
        valid = sel <= t_pos[None, :, None]
        k_sel = gather_rows(k, sel)
        v_sel = gather_rows(v, sel)
        logits = jnp.einsum('bthd,btkhd->bhtk', qb, k_sel).astype(jnp.float32) * scale
        logits = jnp.where(valid[:, None], logits, -jnp.inf)
        p = jax.nn.softmax(logits, axis=-1).astype(v.dtype)
        return jnp.einsum('bhtk,btkhd->bthd', p, v_sel)

    out = unblock(lax.map(block, jnp.arange(seq // Q_BLOCK)))
    return out.reshape(bsz, seq, GROUP_WIDTH)


def gmlp_mixer(u, v, norm_g, w_s, b_s):
    bsz, seq = u.shape[0], u.shape[1]
    u = jax.nn.gelu(u)
    v = jax.nn.gelu(v)
    vf = v.astype(jnp.float32)
    mu = jnp.mean(vf, axis=-1, keepdims=True)
    var = jnp.mean(jnp.square(vf - mu), axis=-1, keepdims=True)
    v = ((vf - mu) * lax.rsqrt(var + EPS)).astype(u.dtype) * norm_g
    v = v.reshape(bsz, seq // CHUNK, CHUNK, GROUP_HEADS, HEAD_DIM)
    w_causal = jnp.where(jnp.tril(jnp.ones((CHUNK, CHUNK), dtype=bool)), w_s, 0)
    mixed = jnp.einsum('hts,bnshd->bnthd', w_causal, v) + jnp.swapaxes(b_s, 0, 1)[:, :, None]
    return u * mixed.reshape(bsz, seq, GROUP_WIDTH)


def pool_mixer(z, w_pool, scale):
    bsz, seq = z.shape[0], z.shape[1]
    zf = z.astype(jnp.float32).reshape(bsz, seq, len(POOL_WINDOWS), POOL_CH)
    csum = jnp.concatenate([jnp.zeros_like(zf[:, :1]), jnp.cumsum(zf, axis=1)], axis=1)
    t = jnp.arange(seq)
    pooled = []
    for g, w in enumerate(POOL_WINDOWS):
        lo = jnp.maximum(t + 1 - w, 0)
        count = (t + 1 - lo).astype(jnp.float32)[None, :, None]
        window_sum = csum[:, 1:, g] - csum[:, lo, g]
        pooled.append(window_sum / count - zf[:, :, g])
    pooled = jnp.stack(pooled, axis=2).astype(z.dtype)
    y = jnp.einsum('blgc,gce->blge', pooled, w_pool)
    return y.reshape(bsz, seq, GROUP_WIDTH) * scale


def nsa_mixer(q, kc, vc, ks, vs, kw, vw, gate_logits, w_cmp1, w_cmp2, cmp_pe, pos):
    bsz, seq = q.shape[0], q.shape[1]
    n_cmp = (seq - CMP_BLOCK) // CMP_STRIDE + 1
    n_sel = seq // SEL_BLOCK
    top_n = min(SEL_TOPN, n_sel)
    scale = HEAD_DIM ** -0.5
    t_all = jnp.arange(seq)
    q = partial_rope(q, pos)

    cmp_start = jnp.arange(n_cmp) * CMP_STRIDE
    cmp_idx = cmp_start[:, None] + jnp.arange(CMP_BLOCK)[None, :]

    def compress(kv, w1, w2, pe):
        blocks = kv[:, cmp_idx] + pe
        return jax.nn.gelu(jnp.einsum('bnjd,jde->bne', blocks, w1)) @ w2

    k_cmp = compress(kc, w_cmp1[0], w_cmp2[0], cmp_pe[0])
    v_cmp = compress(vc, w_cmp1[1], w_cmp2[1], cmp_pe[1])
    k_cmp = partial_rope(k_cmp[:, :, None], pos[:, cmp_start + CMP_BLOCK // 2])[:, :, 0]
    cmp_visible = (cmp_start + CMP_BLOCK - 1)[None, :] <= t_all[:, None]
    logits = jnp.einsum('blhd,bnd->bhln', q, k_cmp).astype(jnp.float32) * scale
    p_cmp = jax.nn.softmax(jnp.where(cmp_visible, logits, NEG), axis=-1)
    p_cmp = jnp.where(cmp_visible.any(-1)[:, None], p_cmp, 0.0)
    o_cmp = jnp.einsum('bhln,bnd->blhd', p_cmp.astype(vc.dtype), v_cmp)

    sel_start = jnp.arange(n_sel) * SEL_BLOCK
    overlap = jnp.clip(jnp.minimum(sel_start[:, None] + SEL_BLOCK, cmp_start[None, :] + CMP_BLOCK)
                       - jnp.maximum(sel_start[:, None], cmp_start[None, :]), 0)
    overlap = overlap.astype(jnp.float32) / CMP_BLOCK
    importance = jnp.einsum('bhln,jn->blj', p_cmp, overlap)
    blk = jnp.arange(n_sel)
    admissible = sel_start[None, :] <= t_all[:, None]
    forced = (blk[None, :] == (t_all // SEL_BLOCK)[:, None]) | (blk[None, :] == 0)
    importance = jnp.where(forced, jnp.inf, importance)
    importance = jnp.where(admissible, importance, -jnp.inf)
    _, sel_idx = lax.top_k(importance, top_n)
    sel_valid = sel_idx * SEL_BLOCK <= t_all[None, :, None]

    ks = partial_rope(ks[:, :, None], pos)[:, :, 0].reshape(bsz, n_sel, SEL_BLOCK, KV_DIM)
    vs = vs.reshape(bsz, n_sel, SEL_BLOCK, KV_DIM)
    kw = partial_rope(kw[:, :, None], pos)[:, :, 0]
    kw_pad = jnp.pad(kw, ((0, 0), (WINDOW, 0), (0, 0)))
    vw_pad = jnp.pad(vw, ((0, 0), (WINDOW, 0), (0, 0)))
    in_block = jnp.arange(SEL_BLOCK)
    win_off = jnp.arange(WINDOW + Q_BLOCK) - WINDOW

    def block(i):
        s0 = i * Q_BLOCK
        t_pos = s0 + jnp.arange(Q_BLOCK)
        qb = lax.dynamic_slice_in_dim(q, s0, Q_BLOCK, 1)
        idx = lax.dynamic_slice_in_dim(sel_idx, s0, Q_BLOCK, 1)
        ok = lax.dynamic_slice_in_dim(sel_valid, s0, Q_BLOCK, 1)
        k_g = gather_rows(ks, idx).reshape(bsz, Q_BLOCK, top_n * SEL_BLOCK, KV_DIM)
        v_g = gather_rows(vs, idx).reshape(bsz, Q_BLOCK, top_n * SEL_BLOCK, KV_DIM)
        key_pos = idx[..., None] * SEL_BLOCK + in_block
        mask = (ok[..., None] & (key_pos <= t_pos[None, :, None, None])).reshape(bsz, Q_BLOCK, -1)
        logits_s = jnp.einsum('bthd,btkd->bhtk', qb, k_g).astype(jnp.float32) * scale
        logits_s = jnp.where(mask[:, None], logits_s, -jnp.inf)
        o_sel = jnp.einsum('bhtk,btkd->bthd', jax.nn.softmax(logits_s, axis=-1).astype(vs.dtype), v_g)
        k_win = lax.dynamic_slice_in_dim(kw_pad, s0, WINDOW + Q_BLOCK, 1)
        v_win = lax.dynamic_slice_in_dim(vw_pad, s0, WINDOW + Q_BLOCK, 1)
        kpos = s0 + win_off
        wmask = ((kpos[None, :] <= t_pos[:, None]) & (kpos[None, :] > t_pos[:, None] - WINDOW)
                 & (kpos[None, :] >= 0))
        logits_w = jnp.einsum('bthd,bsd->bhts', qb, k_win).astype(jnp.float32) * scale
        logits_w = jnp.where(wmask, logits_w, -jnp.inf)
        o_win = jnp.einsum('bhts,bsd->bthd', jax.nn.softmax(logits_w, axis=-1).astype(vw.dtype), v_win)
        return o_sel, o_win

    o_sel, o_win = lax.map(block, jnp.arange(seq // Q_BLOCK))
    o_sel = unblock(o_sel)
    o_win = unblock(o_win)
    g = jax.nn.sigmoid(gate_logits.astype(jnp.float32)).astype(q.dtype)
    out = g[..., 0:1] * o_cmp + g[..., 1:2] * o_sel + g[..., 2:3] * o_win
    return out.reshape(bsz, seq, GROUP_WIDTH)


def moe(h, router_w, router_b, w_gate, w_up, w_down):
    bsz, seq, d = h.shape
    tok = h.reshape(-1, d)
    affinity = jax.nn.sigmoid((tok @ router_w).astype(jnp.float32))
    biased = affinity + router_b.astype(jnp.float32)
    group_score = lax.top_k(biased.reshape(-1, N_EXPERT_GROUPS, EXPERTS_PER_GROUP), TOP_K)[0].sum(-1)
    best_group = jnp.argmax(group_score, axis=-1)
    in_group = (jnp.arange(N_EXPERTS) // EXPERTS_PER_GROUP)[None, :] == best_group[:, None]
    _, top_idx = lax.top_k(jnp.where(in_group, biased, -jnp.inf), TOP_K)
    top_aff = jnp.take_along_axis(affinity, top_idx, axis=-1)
    weights = top_aff / jnp.sum(top_aff, axis=-1, keepdims=True)
    gate = jnp.sum(jax.nn.one_hot(top_idx, N_EXPERTS, dtype=jnp.float32) * weights[..., None], axis=1)
    gate = gate.astype(h.dtype)
    out = jnp.zeros_like(tok)
    for e in range(N_EXPERTS):
        hidden = jax.nn.silu(tok @ w_gate[e]) * (tok @ w_up[e])
        out = out + gate[:, e:e + 1] * (hidden @ w_down[e])
    return out.reshape(bsz, seq, d)


def hybrid_layer(x, c_act, pos, ada_w, ada_b, g_mix, g_ffn, w_in, sgu_g, w_sgu, b_sgu, w_pool, pool_scale,
                 w_cmp1, w_cmp2, cmp_pe, w_out, router_w, router_b, w_gate, w_up, w_down):
    bsz, seq = x.shape[0], x.shape[1]
    mod = c_act @ ada_w + ada_b
    shift_m, scale_m, gate_m, shift_f, scale_f, gate_f = [m[:, None, :] for m in jnp.split(mod, 6, axis=-1)]

    h = rmsnorm(x, g_mix) * (1 + scale_m) + shift_m
    (a_q, a_k, a_v, a_iq, a_ik, a_iw, b_u, b_v, c_z,
     d_q, d_kc, d_vc, d_ks, d_vs, d_kw, d_vw, d_g) = split_projection(h @ w_in)
    o_a = dsa_mixer(a_q.reshape(bsz, seq, GROUP_HEADS, HEAD_DIM), a_k.reshape(bsz, seq, GROUP_HEADS, HEAD_DIM),
                    a_v.reshape(bsz, seq, GROUP_HEADS, HEAD_DIM), a_iq.reshape(bsz, seq, IDX_HEADS, IDX_DIM),
                    a_ik, a_iw, pos)
    o_b = gmlp_mixer(b_u, b_v, sgu_g, w_sgu, b_sgu)
    o_c = pool_mixer(c_z, w_pool, pool_scale)
    o_d = nsa_mixer(d_q.reshape(bsz, seq, GROUP_HEADS, HEAD_DIM), d_kc, d_vc, d_ks, d_vs, d_kw, d_vw,
                    d_g.reshape(bsz, seq, GROUP_HEADS, 3), w_cmp1, w_cmp2, cmp_pe, pos)
    mixed = jnp.concatenate([o_a, o_b, o_c, o_d], axis=-1) @ w_out
    x = x + gate_m * mixed

    h = rmsnorm(x, g_ffn) * (1 + scale_f) + shift_f
    return x + gate_f * moe(h, router_w, router_b, w_gate, w_up, w_down)


def setup_inputs(seed: int = 0) -> dict:
    key = jax.random.key(seed)
    ks = jax.random.split(key, 24)

    def nrm(k, shape, s):
        return jax.random.normal(k, shape, jnp.float32) * s

    def gain(k, shape):
        return 1.0 + nrm(k, shape, 0.02)

    return {
        'x': nrm(ks[0], (BATCH, SEQ, D_MODEL), 1.0),
        'c': nrm(ks[1], (BATCH, D_MODEL), 1.0),
        'positions': jnp.arange(SEQ, dtype=jnp.int32)[None, :]
                     + jax.random.randint(ks[2], (BATCH, 1), 0, 1024, dtype=jnp.int32),
        'ada_w': nrm(ks[3], (DEPTH, D_MODEL, 6 * D_MODEL), 0.5 * D_MODEL ** -0.5),
        'ada_b': nrm(ks[4], (DEPTH, 6 * D_MODEL), 0.02),
        'norm_mix_g': gain(ks[5], (DEPTH, D_MODEL)),
        'norm_ffn_g': gain(ks[6], (DEPTH, D_MODEL)),
        'w_in': nrm(ks[7], (DEPTH, D_MODEL, IN_WIDTH), D_MODEL ** -0.5),
        'sgu_norm_g': gain(ks[8], (DEPTH, GROUP_WIDTH)),
        'w_sgu': nrm(ks[9], (DEPTH, GROUP_HEADS, CHUNK, CHUNK), CHUNK ** -0.5),
        'b_sgu': gain(ks[10], (DEPTH, GROUP_HEADS, CHUNK)),
        'w_pool': nrm(ks[11], (DEPTH, len(POOL_WINDOWS), POOL_CH, POOL_CH), POOL_CH ** -0.5),
        'pool_scale': 1.0 + nrm(ks[12], (DEPTH, GROUP_WIDTH), 0.1),
        'w_cmp1': nrm(ks[13], (DEPTH, 2, CMP_BLOCK, KV_DIM, KV_DIM), (CMP_BLOCK * KV_DIM) ** -0.5),
        'w_cmp2': nrm(ks[14], (DEPTH, 2, KV_DIM, KV_DIM), KV_DIM ** -0.5),
        'cmp_pe': nrm(ks[15], (DEPTH, 2, CMP_BLOCK, KV_DIM), 0.1),
        'w_out': nrm(ks[16], (DEPTH, D_MIX, D_MODEL), D_MIX ** -0.5),
        'router_w': nrm(ks[17], (D_MODEL, N_EXPERTS), D_MODEL ** -0.5),
        'router_b': nrm(ks[18], (N_EXPERTS,), 0.01),
        'w_gate': nrm(ks[19], (DEPTH, N_EXPERTS, D_MODEL, D_EXPERT), D_MODEL ** -0.5),
        'w_up': nrm(ks[20], (DEPTH, N_EXPERTS, D_MODEL, D_EXPERT), D_MODEL ** -0.5),
        'w_down': nrm(ks[21], (DEPTH, N_EXPERTS, D_EXPERT, D_MODEL), D_EXPERT ** -0.5),
        'final_norm_g': gain(ks[22], (D_MODEL,)),
    }


def reference(x, c, positions, ada_w, ada_b, norm_mix_g, norm_ffn_g, w_in, sgu_norm_g, w_sgu, b_sgu, w_pool,
              pool_scale, w_cmp1, w_cmp2, cmp_pe, w_out, router_w, router_b, w_gate, w_up, w_down, final_norm_g):
    c_act = jax.nn.silu(c)
    for layer in range(DEPTH):
        x = hybrid_layer(x, c_act, positions, ada_w[layer], ada_b[layer], norm_mix_g[layer], norm_ffn_g[layer],
                         w_in[layer], sgu_norm_g[layer], w_sgu[layer], b_sgu[layer], w_pool[layer],
                         pool_scale[layer], w_cmp1[layer], w_cmp2[layer], cmp_pe[layer], w_out[layer],
                         router_w, router_b, w_gate[layer], w_up[layer], w_down[layer])
    return rmsnorm(x, final_norm_g)
```

```cpp
#include <hip/hip_runtime.h>
#include <hip/hip_cooperative_groups.h>
#include <cstdio>
#include <cstdint>
namespace cg = cooperative_groups;

#ifndef COOP
#define COOP 1
#ifndef TKCHECK
#define TKCHECK 0
#endif
#endif

typedef unsigned short u16;
typedef unsigned int u32;
typedef unsigned long long u64;
typedef short bf16x8 __attribute__((ext_vector_type(8)));
typedef float f32x4 __attribute__((ext_vector_type(4)));
typedef float f32x16 __attribute__((ext_vector_type(16)));
typedef u32 u32x4 __attribute__((ext_vector_type(4)));
typedef u32 u32x2 __attribute__((ext_vector_type(2)));
#define DI __device__ __forceinline__
#define LAS __attribute__((address_space(3)))
constexpr int SMEM_BYTES = 75776;

constexpr int NB = 4, SEQ = 4096, DM = 1024, NTOK = NB * SEQ;
constexpr int ZW = 2432;
constexpr int ZC_AQ = 0, ZC_AK = 256, ZC_AV = 512, ZC_IQ = 768, ZC_IK = 896, ZC_IW = 928, ZC_DG = 932, ZC_BU = 960, ZC_BV = 1216,
              ZC_CZ = 1472, ZC_DQ = 1728, ZC_KC = 1984, ZC_VC = 2048, ZC_KS = 2112, ZC_VS = 2176, ZC_KW = 2240, ZC_VW = 2304, ZC_END = 2368;
constexpr int IN_WIDTH = 2352;
constexpr int NCLS = 24;

constexpr size_t al256(size_t x) { return (x + 255) & ~(size_t)255; }
constexpr size_t OFF_WIN = 0;
constexpr size_t OFF_WOUT = OFF_WIN + 2ull * ZW * 1024 * 2;
constexpr size_t OFF_WGU = OFF_WOUT + 2ull * 1024 * 1024 * 2;
constexpr size_t OFF_WD = OFF_WGU + 2ull * 16 * 512 * 1024 * 2;
constexpr size_t OFF_WSGU = OFF_WD + 2ull * 16 * 1024 * 256 * 2;
constexpr size_t OFF_MOD = OFF_WSGU + 2ull * 4 * 128 * 128 * 2;
constexpr size_t OFF_ROPE = OFF_MOD + 2ull * 4 * 6144 * 4;
constexpr size_t OFF_H = OFF_ROPE + (size_t)NTOK * 8 * 8;
constexpr size_t OFF_Z = OFF_H + (size_t)NTOK * 1024 * 2;
constexpr size_t OFF_VTA = OFF_Z + (size_t)NTOK * ZW * 2;
constexpr size_t OFF_VTS = OFF_VTA + 4ull * 4 * 64 * 4096 * 2;
constexpr size_t OFF_VTW = OFF_VTS + 4ull * 64 * 4096 * 2;
constexpr size_t OFF_KCMP = OFF_VTW + 4ull * 64 * 4096 * 2;
constexpr size_t OFF_VCMPT = OFF_KCMP + 4ull * 256 * 64 * 2;
constexpr size_t OFF_MASK = OFF_VCMPT + 4ull * 64 * 256 * 2;
constexpr size_t OFF_CONCAT = OFF_MASK + 4ull * 64 * 4096 * 8;
constexpr size_t OFF_LIST = OFF_CONCAT + (size_t)NTOK * 1024 * 2;
constexpr size_t OFF_TOKW = OFF_LIST + 2ull * NCLS * NTOK * 4;
constexpr size_t OFF_CNT = OFF_TOKW + (size_t)NTOK * 2 * 4;
constexpr size_t OFF_IKC = OFF_CNT + 1024;
constexpr size_t OFF_PARK = OFF_IKC + (size_t)NTOK * 32 * 2;
constexpr size_t OFF_BAR = OFF_PARK + 512ull * 32 * 256 * 4;
constexpr size_t WS_END = OFF_BAR + 16384;
constexpr size_t OFF_HID = OFF_Z;

struct Params {
    const float *x, *c; const int* pos;
    const float *ada_w, *ada_b, *g_mix, *g_ffn, *w_in, *sgu_g, *w_sgu, *b_sgu, *w_pool, *pool_scale, *w_cmp1, *w_cmp2, *cmp_pe,
                *w_out, *router_w, *router_b, *w_gate, *w_up, *w_down, *final_g;
    float* out; unsigned char* ws;
    int ph_lo, ph_hi;
};

typedef __bf16 hbf16x2 __attribute__((ext_vector_type(2)));
typedef float f32x2v __attribute__((ext_vector_type(2)));
DI u16 f2bf(float f) { return __builtin_bit_cast(u16, (__bf16)f); }
DI float bf2f(u16 h) { return __uint_as_float(((u32)h) << 16); }
DI u32 pack2(float a, float b) { const f32x2v v = {a, b}; return __builtin_bit_cast(u32, __builtin_convertvector(v, hbf16x2)); }
DI float wave_sum(float v) {
#pragma unroll
    for (int o = 32; o; o >>= 1) v += __shfl_xor(v, o);
    return v;
}
DI int otid() { int t = threadIdx.x; asm volatile("" : "+v"(t)); return t; }
DI int block_or(int pred, unsigned char* smem) {
    volatile int* f = (volatile int*)(smem + SMEM_BYTES - 48);
    __syncthreads();
    if (threadIdx.x == 0) *f = 0;
    __syncthreads();
    if (pred) *f = 1;
    __syncthreads();
    return *f;
}
DI void wave_lds_fence() { asm volatile("s_waitcnt lgkmcnt(0)" ::: "memory"); }
DI float gelu_tanh(float x) { const float u = 0.7978845608028654f * (x + 0.044715f * x * x * x);
    return x * __builtin_amdgcn_rcpf(1.f + __builtin_amdgcn_exp2f(-2.885390081777927f * u)); }
DI float sigmoidf_(float x) { return 1.f / (1.f + __expf(-x)); }
DI int perm16(int k) { return ((k & 4) << 1) | ((k & 8) >> 1) | (k & 3); }
#define MFMA16(a, b, c) __builtin_amdgcn_mfma_f32_16x16x32_bf16((a), (b), (c), 0, 0, 0)
#define MFMA32(a, b, c) __builtin_amdgcn_mfma_f32_32x32x16_bf16((a), (b), (c), 0, 0, 0)

DI int win_colmap(int n) { return n < 932 ? n : (n < 944 ? 2340 + (n - 932) : (n < 960 ? -1 : (n < ZC_END ? n - 28 : -1))); }

constexpr int P0_T_WIN = 2 * (ZW / 64) * 16;
constexpr int P0_T_WOUT = 2 * 16 * 16;
constexpr int P0_T_WGU = 2 * 16 * 8 * 16;
constexpr int P0_T_WD = 2 * 16 * 16 * 4;
constexpr int P0_TILES = P0_T_WIN + P0_T_WOUT + P0_T_WGU + P0_T_WD;
constexpr int P0_MOD = 2 * 96;
constexpr int P0_ROPE = NTOK * 8 / 256;
constexpr int P0_SGU = 2 * 4 * 128 * 128 / 2048;
constexpr int P0_ITEMS = P0_TILES + P0_MOD + P0_ROPE + P0_SGU + 1;

DI void wtile(const Params& p, int t, unsigned char* smem, const int tid) {
    const float* src; u16* dst; int ldsrc, Kdim, n0, k0, kind, l, e = 0;
    if (t < P0_T_WIN) { kind = 0; l = t / 608; int r = t % 608; n0 = (r / 16) * 64; k0 = (r % 16) * 64; src = p.w_in + (size_t)l * 1024 * IN_WIDTH; ldsrc = IN_WIDTH; Kdim = 1024;
        dst = (u16*)(p.ws + OFF_WIN) + (size_t)l * ZW * 1024; }
    else if ((t -= P0_T_WIN) < P0_T_WOUT) { kind = 1; l = t / 256; int r = t % 256; n0 = (r / 16) * 64; k0 = (r % 16) * 64; src = p.w_out + (size_t)l * 1024 * 1024; ldsrc = 1024; Kdim = 1024;
        dst = (u16*)(p.ws + OFF_WOUT) + (size_t)l * 1024 * 1024; }
    else if ((t -= P0_T_WOUT) < P0_T_WGU) { kind = 2; l = t / 2048; int r = t % 2048; e = r / 128; r %= 128; n0 = (r / 16) * 64; k0 = (r % 16) * 64; src = nullptr; ldsrc = 256; Kdim = 1024;
        dst = (u16*)(p.ws + OFF_WGU) + (size_t)(l * 16 + e) * 512 * 1024; }
    else { t -= P0_T_WGU; kind = 3; l = t / 1024; int r = t % 1024; e = r / 64; r %= 64; n0 = (r / 4) * 64; k0 = (r % 4) * 64; src = p.w_down + (size_t)(l * 16 + e) * 256 * 1024; ldsrc = 1024; Kdim = 256;
        dst = (u16*)(p.ws + OFF_WD) + (size_t)(l * 16 + e) * 1024 * 256; }
    float* tile = (float*)smem;
    __syncthreads();
    if (kind == 1 || kind == 3) {
#pragma unroll
        for (int i = 0; i < 4; ++i) {
            const int k = i * 16 + (tid >> 4), c4 = (tid & 15) * 4;
            const f32x4 v = *(const f32x4*)(src + (size_t)(k0 + k) * ldsrc + n0 + c4);
            *(f32x4*)(tile + k * 68 + c4) = v;
        }
    } else {
        const int nn = tid & 63;
#pragma unroll 4
        for (int i = 0; i < 16; ++i) {
            const int k = i * 4 + (tid >> 6);
            float v = 0.f;
            const int n = n0 + nn;
            if (kind == 0) { const int c = win_colmap(n); if (c >= 0) v = src[(size_t)(k0 + k) * ldsrc + c]; }
            else { const int t16 = n >> 4, col = (t16 >> 1) * 16 + (n & 15); const float* s2 = ((t16 & 1) ? p.w_up : p.w_gate) + (size_t)(l * 16 + e) * 1024 * 256; v = s2[(size_t)(k0 + k) * 256 + col]; }
            tile[k * 68 + nn] = v;
        }
    }
    __syncthreads();
#pragma unroll
    for (int i = 0; i < 2; ++i) {
        const int n = i * 32 + (tid >> 3), k8 = (tid & 7) * 8;
        u32x4 o;
#pragma unroll
        for (int j = 0; j < 4; ++j) o[j] = pack2(tile[(k8 + 2 * j) * 68 + n], tile[(k8 + 2 * j + 1) * 68 + n]);
        *(u32x4*)(dst + (size_t)(n0 + n) * Kdim + k0 + k8) = o;
    }
}
constexpr int P0_NOW = 608;
constexpr int WT_DEFER = (P0_TILES - P0_NOW) / 8;
DI void phase0(const Params& p, unsigned char* smem) {
    const int tid = otid();
    for (int it = blockIdx.x; it < P0_ITEMS; it += gridDim.x) {
        if (it < P0_TILES) {
            if (it < P0_NOW) wtile(p, it, smem, tid);
        } else if (it < P0_TILES + P0_MOD) {
            const int t = it - P0_TILES, l = t / 96, n0 = (t % 96) * 64;
            float* sc = (float*)smem;
            float* red = sc + 4096;
            __syncthreads();
            for (int i = tid; i < 4096; i += 256) { const float cv = p.c[i]; sc[i] = cv / (1.f + __expf(-cv)); }
            __syncthreads();
            const int col = n0 + (tid & 63), kq = tid >> 6;
            float a0 = 0.f, a1 = 0.f, a2 = 0.f, a3 = 0.f;
            const float* w = p.ada_w + (size_t)l * 1024 * 6144 + col;
#pragma unroll 8
            for (int k = kq * 256; k < kq * 256 + 256; ++k) { const float wv = w[(size_t)k * 6144]; a0 += sc[k] * wv; a1 += sc[1024 + k] * wv; a2 += sc[2048 + k] * wv; a3 += sc[3072 + k] * wv; }
            red[(kq * 4 + 0) * 64 + (tid & 63)] = a0; red[(kq * 4 + 1) * 64 + (tid & 63)] = a1; red[(kq * 4 + 2) * 64 + (tid & 63)] = a2; red[(kq * 4 + 3) * 64 + (tid & 63)] = a3;
            __syncthreads();
            { const int b = tid >> 6, cc = tid & 63; float s = red[(0 * 4 + b) * 64 + cc] + red[(1 * 4 + b) * 64 + cc] + red[(2 * 4 + b) * 64 + cc] + red[(3 * 4 + b) * 64 + cc];
              ((float*)(p.ws + OFF_MOD))[(size_t)(l * 4 + b) * 6144 + n0 + cc] = s + p.ada_b[(size_t)l * 6144 + n0 + cc]; }
        } else if (it < P0_TILES + P0_MOD + P0_ROPE) {
            const int idx = (it - P0_TILES - P0_MOD) * 256 + tid, tok = idx >> 3, i = idx & 7;
            const double inv = exp(-((double)i / 8.0) * log(500000.0));
            const double ang = (double)p.pos[tok] * inv;
            float2 cs; cs.x = (float)cos(ang); cs.y = (float)sin(ang);
            ((float2*)(p.ws + OFF_ROPE))[idx] = cs;
        } else if (it < P0_TILES + P0_MOD + P0_ROPE + P0_SGU) {
            const int base = (it - P0_TILES - P0_MOD - P0_ROPE) * 2048;
            for (int i = tid; i < 2048; i += 256) { const int idx = base + i, s = idx & 127, t = (idx >> 7) & 127; ((u16*)(p.ws + OFF_WSGU))[idx] = (s <= t) ? f2bf(p.w_sgu[idx]) : (u16)0; }
        } else {
            if (tid < 128) ((int*)(p.ws + OFF_CNT))[tid] = 0;
        }
    }
}

template <int MODE> DI void phase_rownorm(const Params& p, int layer) {
    const int tid0 = otid(); const int lane = tid0 & 63, wave = tid0 >> 6;
    const float* src = (MODE == 0 && layer == 0) ? p.x : p.out;
    const float* mod = (const float*)(p.ws + OFF_MOD);
    for (int row = blockIdx.x * 4 + wave; row < NTOK; row += gridDim.x * 4) {
        const int b = row >> 12;
        float4 v[4];
#pragma unroll
        for (int i = 0; i < 4; ++i) v[i] = *(const float4*)(src + (size_t)row * 1024 + 4 * lane + 256 * i);
        float ss = 0.f;
#pragma unroll
        for (int i = 0; i < 4; ++i) ss += v[i].x * v[i].x + v[i].y * v[i].y + v[i].z * v[i].z + v[i].w * v[i].w;
        ss = wave_sum(ss);
        const float rstd = rsqrtf(ss * (1.f / 1024.f) + 1e-6f);
        if (MODE == 2) {
#pragma unroll
            for (int i = 0; i < 4; ++i) { const float4 g = *(const float4*)(p.final_g + 4 * lane + 256 * i); float4 o; o.x = v[i].x * rstd * g.x; o.y = v[i].y * rstd * g.y; o.z = v[i].z * rstd * g.z; o.w = v[i].w * rstd * g.w;
                *(float4*)(p.out + (size_t)row * 1024 + 4 * lane + 256 * i) = o; }
        } else {
            const float* gg = p.g_mix + (size_t)layer * 1024;
            const float* msh = mod + (size_t)(layer * 4 + b) * 6144;
            const float* msc = msh + 1024;
            u16* hrow = (u16*)(p.ws + OFF_H) + (size_t)row * 1024;
#pragma unroll
            for (int i = 0; i < 4; ++i) {
                const int c0 = 4 * lane + 256 * i;
                const float4 g = *(const float4*)(gg + c0), sh = *(const float4*)(msh + c0), sc = *(const float4*)(msc + c0);
                uint2 pk; pk.x = pack2(v[i].x * rstd * g.x * (1.f + sc.x) + sh.x, v[i].y * rstd * g.y * (1.f + sc.y) + sh.y);
                pk.y = pack2(v[i].z * rstd * g.z * (1.f + sc.z) + sh.z, v[i].w * rstd * g.w * (1.f + sc.w) + sh.w);
                *(uint2*)(hrow + c0) = pk;
            }
        }
    }
}
template <bool DRY> DI void phase_router(const Params& p, int layer, unsigned char* smem) {
    const int tid0 = otid(); const int lane = tid0 & 63, wave = tid0 >> 6;
    const float* mod = (const float*)(p.ws + OFF_MOD);
    const float* gg = p.g_ffn + (size_t)layer * 1024;
    float* rwT = (float*)smem;
    __syncthreads();
    for (int i = tid0; i < 4096; i += 256) {
        const f32x4 v = ((const f32x4*)p.router_w)[i];
        const int k = i >> 2, e0 = (i & 3) * 4;
        rwT[(e0 + 0) * 1024 + k] = v[0]; rwT[(e0 + 1) * 1024 + k] = v[1]; rwT[(e0 + 2) * 1024 + k] = v[2]; rwT[(e0 + 3) * 1024 + k] = v[3];
    }
    __syncthreads();
    for (int rg = blockIdx.x * 4 + wave; rg < NTOK / 4; rg += gridDim.x * 4) {
        const int row0 = rg * 4, b = row0 >> 12;
        const float* msh = mod + (size_t)(layer * 4 + b) * 6144 + 3 * 1024;
        const float* msc = msh + 1024;
        float rstd[4];
#pragma unroll
        for (int r = 0; r < 4; ++r) {
            float ss = 0.f;
#pragma unroll
            for (int i = 0; i < 4; ++i) { const float4 xv = *(const float4*)(p.out + (size_t)(row0 + r) * 1024 + 4 * lane + 256 * i); ss += xv.x * xv.x + xv.y * xv.y + xv.z * xv.z + xv.w * xv.w; }
            ss = wave_sum(ss);
            rstd[r] = rsqrtf(ss * (1.f / 1024.f) + 1e-6f);
        }
        float part[4][16];
#pragma unroll
        for (int r = 0; r < 4; ++r)
#pragma unroll
            for (int e = 0; e < 16; ++e) part[r][e] = 0.f;
#pragma unroll 1
        for (int i = 0; i < 4; ++i) {
            const int c0 = 4 * lane + 256 * i;
            const float4 g = *(const float4*)(gg + c0), sh = *(const float4*)(msh + c0), sc = *(const float4*)(msc + c0);
            const float gs[4] = {g.x * (1.f + sc.x), g.y * (1.f + sc.y), g.z * (1.f + sc.z), g.w * (1.f + sc.w)};
            const float shv[4] = {sh.x, sh.y, sh.z, sh.w};
            float hv[4][4];
#pragma unroll
            for (int r = 0; r < 4; ++r) {
                const float4 xv = *(const float4*)(p.out + (size_t)(row0 + r) * 1024 + c0);
                const float xr[4] = {xv.x, xv.y, xv.z, xv.w};
#pragma unroll
                for (int j = 0; j < 4; ++j) hv[r][j] = xr[j] * rstd[r] * gs[j] + shv[j];
                uint2 pk; pk.x = pack2(hv[r][0], hv[r][1]); pk.y = pack2(hv[r][2], hv[r][3]);
                *(uint2*)((u16*)(p.ws + OFF_H) + (size_t)(row0 + r) * 1024 + c0) = pk;
            }
#pragma unroll
            for (int e = 0; e < 16; ++e) {
                if ((e & 3) == 0) asm volatile("" ::: "memory");
                const f32x4 w4 = *(const f32x4*)(rwT + e * 1024 + c0);
#pragma unroll
                for (int r = 0; r < 4; ++r) part[r][e] += hv[r][0] * w4[0] + hv[r][1] * w4[1] + hv[r][2] * w4[2] + hv[r][3] * w4[3];
            }
        }
#pragma unroll
        for (int r = 0; r < 4; ++r) {
            float v8[8], v4[4], v2[2];
            const bool h5 = (lane & 32) != 0, h4 = (lane & 16) != 0, h3 = (lane & 8) != 0, h2 = (lane & 4) != 0;
#pragma unroll
            for (int e = 0; e < 8; ++e) { const float mine = h5 ? part[r][e + 8] : part[r][e], send = h5 ? part[r][e] : part[r][e + 8]; v8[e] = mine + __shfl_xor(send, 32); }
#pragma unroll
            for (int e = 0; e < 4; ++e) { const float mine = h4 ? v8[e + 4] : v8[e], send = h4 ? v8[e] : v8[e + 4]; v4[e] = mine + __shfl_xor(send, 16); }
#pragma unroll
            for (int e = 0; e < 2; ++e) { const float mine = h3 ? v4[e + 2] : v4[e], send = h3 ? v4[e] : v4[e + 2]; v2[e] = mine + __shfl_xor(send, 8); }
            float v1 = (h2 ? v2[1] : v2[0]) + __shfl_xor(h2 ? v2[0] : v2[1], 4);
            v1 += __shfl_xor(v1, 2); v1 += __shfl_xor(v1, 1);
            float aff[16], bia[16];
#pragma unroll
            for (int e = 0; e < 16; ++e) { const float lg = __int_as_float(__builtin_amdgcn_readlane(__float_as_int(v1), 4 * e)); aff[e] = 1.f / (1.f + expf(-lg)); bia[e] = aff[e] + p.router_b[e]; }
            int bg = 0; float bs = -INFINITY;
#pragma unroll
            for (int g = 0; g < 4; ++g) {
                const float a0 = bia[4 * g], a1 = bia[4 * g + 1], a2 = bia[4 * g + 2], a3 = bia[4 * g + 3];
                const float hi01 = fmaxf(a0, a1), lo01 = fminf(a0, a1), hi23 = fmaxf(a2, a3), lo23 = fminf(a2, a3);
                const float t1 = fmaxf(hi01, hi23), t2 = fmaxf(fminf(hi01, hi23), fmaxf(lo01, lo23));
                const float gsum = t1 + t2;
                if (gsum > bs) { bs = gsum; bg = g; }
            }
            float cb[4], ca[4];
#pragma unroll
            for (int i = 0; i < 4; ++i) { cb[i] = bia[i]; ca[i] = aff[i]; }
#pragma unroll
            for (int g = 1; g < 4; ++g)
#pragma unroll
                for (int i = 0; i < 4; ++i) if (bg == g) { cb[i] = bia[4 * g + i]; ca[i] = aff[4 * g + i]; }
            int i1 = 0; float m1 = cb[0];
#pragma unroll
            for (int i = 1; i < 4; ++i) if (cb[i] > m1) { m1 = cb[i]; i1 = i; }
            int i2 = -1; float m2 = -INFINITY;
#pragma unroll
            for (int i = 0; i < 4; ++i) if (i != i1 && cb[i] > m2) { m2 = cb[i]; i2 = i; }
            float af1 = ca[0], af2 = ca[0];
#pragma unroll
            for (int i = 1; i < 4; ++i) { if (i1 == i) af1 = ca[i]; if (i2 == i) af2 = ca[i]; }
            const float inv = 1.f / (af1 + af2);
            const int lo = min(i1, i2), hi = max(i1, i2);
            const float wlo = (lo == i1 ? af1 : af2) * inv, whi = (hi == i1 ? af1 : af2) * inv;
            const int cls = bg * 6 + lo * (7 - lo) / 2 + (hi - lo - 1);
            if (lane == 0) {
                float2 tw; tw.x = wlo; tw.y = whi;
                ((float2*)(p.ws + OFF_TOKW))[row0 + r] = tw;
                if (!DRY) {
                    int* cnt = (int*)(p.ws + OFF_CNT) + layer * 32;
                    const int pos = atomicAdd(&cnt[cls], 1);
                    ((int*)(p.ws + OFF_LIST))[(size_t)(layer * NCLS + cls) * NTOK + pos] = row0 + r;
                }
            }
        }
    }
}

#define GAS __attribute__((address_space(1)))
constexpr int GSTAGE = 32768;
constexpr int GEMM_LDS = 2 * GSTAGE;
DI void gemm_core(const int tid, const u16* __restrict__ A, const size_t (&aoff)[4], const u16* __restrict__ Bt, const size_t (&boff)[4], int K, unsigned char* smem, f32x4 (&acc)[4][4],
                  const u16* __restrict__ A2 = nullptr, const u16* __restrict__ Bt2 = nullptr, int ksplit = 1 << 30) {
    const int lane = tid & 63, wave = __builtin_amdgcn_readfirstlane(tid >> 6), wr = wave >> 1, wc = wave & 1, l16 = lane & 15, fq = lane >> 4;
    const int csrc = ((lane & 7) ^ ((lane >> 3) & 7)) * 8;
    auto issue = [&](int k0, int stg) {
        unsigned char* base = smem + stg * GSTAGE + wave * 4096;
        const bool second = k0 >= ksplit;
        const u16* Ap = (second ? A2 - ksplit : A) + k0 + csrc;
        const u16* Bp = (second ? Bt2 - ksplit : Bt) + k0 + csrc;
#pragma unroll
        for (int i = 0; i < 4; ++i) {
            __builtin_amdgcn_global_load_lds((const GAS void*)(Ap + aoff[i]), (LAS void*)(base + i * 1024), 16, 0, 0);
            __builtin_amdgcn_global_load_lds((const GAS void*)(Bp + boff[i]), (LAS void*)(base + 16384 + i * 1024), 16, 0, 0);
        }
    };
    __syncthreads();
    issue(0, 0);
    const int nk = K >> 6;
    const int sw = l16 & 7;
    for (int kt = 0; kt < nk; ++kt) {
        __syncthreads();
        if (kt + 1 < nk) issue((kt + 1) << 6, (kt + 1) & 1);
        const unsigned char* sA = smem + (kt & 1) * GSTAGE;
        const unsigned char* sB = sA + 16384;
#pragma unroll
        for (int ks = 0; ks < 2; ++ks) {
            bf16x8 af[4], bfr[4];
            const int coff = ((ks * 4 + fq) ^ sw) * 16;
#pragma unroll
            for (int mi = 0; mi < 4; ++mi) af[mi] = *(const bf16x8*)(sA + (wr * 64 + mi * 16 + l16) * 128 + coff);
#pragma unroll
            for (int ni = 0; ni < 4; ++ni) bfr[ni] = *(const bf16x8*)(sB + (wc * 64 + ni * 16 + l16) * 128 + coff);
#pragma unroll
            for (int mi = 0; mi < 4; ++mi)
#pragma unroll
                for (int ni = 0; ni < 4; ++ni) acc[mi][ni] = MFMA16(bfr[ni], af[mi], acc[mi][ni]);
        }
    }
}
DI bool xcd_next(int r, int total, int& it) {
    const int g = blockIdx.x & 7, lb = blockIdx.x >> 3, nb = gridDim.x >> 3, per = (total + 7) >> 3;
    const int idx = r * nb + lb;
    if (idx >= per) return false;
    it = g * per + idx;
    return true;
}
DI void zero_acc(f32x4 (&acc)[4][4]) {
#pragma unroll
    for (int mi = 0; mi < 4; ++mi)
#pragma unroll
        for (int ni = 0; ni < 4; ++ni) acc[mi][ni] = (f32x4){0.f, 0.f, 0.f, 0.f};
}

DI void phase_inproj(const Params& p, int layer, unsigned char* smem) {
    const int tid = otid(), lane = tid & 63, wave = tid >> 6, wr = wave >> 1, wc = wave & 1, l16 = lane & 15, fq = lane >> 4;
    const u16* H = (const u16*)(p.ws + OFF_H);
    const u16* W = (const u16*)(p.ws + OFF_WIN) + (size_t)layer * ZW * 1024;
    u16* Z = (u16*)(p.ws + OFF_Z);
    const float2* rope = (const float2*)(p.ws + OFF_ROPE);
    constexpr int NT = ZW / 128;
    for (int r = 0;; ++r) {
        int it; if (!xcd_next(r, 128 * NT, it)) break;
        if (it >= 128 * NT) continue;
        const int mt = it / NT, nt = it % NT, m0 = mt * 128, n0 = nt * 128;
        size_t aoff[4], boff[4];
#pragma unroll
        for (int i = 0; i < 4; ++i) { const int r = (wave * 4 + i) * 8 + ((tid >> 3) & 7); aoff[i] = (size_t)(m0 + r) * 1024; boff[i] = (size_t)(n0 + r) * 1024; }
        f32x4 acc[4][4]; zero_acc(acc);
        gemm_core(tid, H, aoff, W, boff, 1024, smem, acc);
#pragma unroll
        for (int ni = 0; ni < 4; ++ni) {
            const int cb = n0 + wc * 64 + ni * 16;
            if (cb >= ZC_END) continue;
            int op = 0;
            if (cb < 512 || (cb >= ZC_DQ && cb < ZC_KC) || (cb >= ZC_KS && cb < ZC_VS) || (cb >= ZC_KW && cb < ZC_VW)) op = ((cb & 63) == 0) ? 1 : 0;
            else if (cb >= ZC_AV && cb < ZC_IQ) op = 4;
            else if (cb >= ZC_IQ && cb < ZC_IW) op = ((cb & 31) == 0) ? 2 : 0;
            else if (cb >= ZC_BU && cb < ZC_CZ) op = 3;
            else if (cb >= ZC_VS && cb < ZC_KW) op = 5;
            else if (cb >= ZC_VW && cb < ZC_END) op = 6;
#pragma unroll
            for (int mi = 0; mi < 4; ++mi) {
                const int row = m0 + wr * 64 + mi * 16 + l16;
                f32x4 v = acc[mi][ni];
                if (op == 1) {
                    f32x4 pv; pv[0] = __shfl_xor(v[0], 32); pv[1] = __shfl_xor(v[1], 32); pv[2] = __shfl_xor(v[2], 32); pv[3] = __shfl_xor(v[3], 32);
                    const float2* cs = rope + (size_t)row * 8 + 4 * (fq & 1);
                    const float sgn = (fq < 2) ? -1.f : 1.f;
#pragma unroll
                    for (int j = 0; j < 4; ++j) { const float2 c2 = cs[j]; v[j] = v[j] * c2.x + sgn * pv[j] * c2.y; }
                } else if (op == 2) {
                    f32x4 pv; pv[0] = __shfl_xor(v[0], 16); pv[1] = __shfl_xor(v[1], 16); pv[2] = __shfl_xor(v[2], 16); pv[3] = __shfl_xor(v[3], 16);
                    if (fq < 2) {
                        const float2* cs = rope + (size_t)row * 8;
                        const float sgn = (fq == 0) ? -1.f : 1.f;
#pragma unroll
                        for (int j = 0; j < 4; ++j) { const float2 c2 = cs[2 * j]; v[j] = v[j] * c2.x + sgn * pv[j] * c2.y; }
                    }
                } else if (op == 3) {
#pragma unroll
                    for (int j = 0; j < 4; ++j) v[j] = gelu_tanh(v[j]);
                }
                if (op >= 4) {
                    const int b = row >> 12, t = row & 4095, tp = (t & ~15) | perm16(t & 15);
                    u16* vt; int ch;
                    if (op == 4) { ch = cb - ZC_AV + 4 * fq; vt = (u16*)(p.ws + OFF_VTA) + ((size_t)b * 256 + ch) * 4096; }
                    else if (op == 5) { ch = cb - ZC_VS + 4 * fq; vt = (u16*)(p.ws + OFF_VTS) + ((size_t)b * 64 + ch) * 4096; }
                    else { ch = cb - ZC_VW + 4 * fq; vt = (u16*)(p.ws + OFF_VTW) + ((size_t)b * 64 + ch) * 4096; }
#pragma unroll
                    for (int j = 0; j < 4; ++j) vt[(size_t)j * 4096 + tp] = f2bf(v[j]);
                } else {
                    uint2 pk; pk.x = pack2(v[0], v[1]); pk.y = pack2(v[2], v[3]);
                    if (cb >= ZC_IK && cb < ZC_IW) *(uint2*)((u16*)(p.ws + OFF_IKC) + (size_t)row * 32 + (cb - ZC_IK) + 4 * fq) = pk;
                    else *(uint2*)(Z + (size_t)row * ZW + cb + 4 * fq) = pk;
                }
            }
        }
    }
}

DI void phase_outproj(const Params& p, int layer, unsigned char* smem) {
    const int tid = otid(), lane = tid & 63, wave = tid >> 6, wr = wave >> 1, wc = wave & 1, l16 = lane & 15, fq = lane >> 4;
    const u16* Cc = (const u16*)(p.ws + OFF_CONCAT);
    const u16* W = (const u16*)(p.ws + OFF_WOUT) + (size_t)layer * 1024 * 1024;
    const float* xin = (layer == 0) ? p.x : p.out;
    const float* mod = (const float*)(p.ws + OFF_MOD);
    for (int r = 0;; ++r) {
        int it; if (!xcd_next(r, 128 * 8, it)) break;
        if (it >= 128 * 8) continue;
        const int mt = it >> 3, nt = it & 7, m0 = mt * 128, n0 = nt * 128;
        size_t aoff[4], boff[4];
#pragma unroll
        for (int i = 0; i < 4; ++i) { const int r = (wave * 4 + i) * 8 + ((tid >> 3) & 7); aoff[i] = (size_t)(m0 + r) * 1024; boff[i] = (size_t)(n0 + r) * 1024; }
        f32x4 acc[4][4]; zero_acc(acc);
        gemm_core(tid, Cc, aoff, W, boff, 1024, smem, acc);
        const int b = m0 >> 12;
        const float* gate = mod + (size_t)(layer * 4 + b) * 6144 + 2 * 1024;
#pragma unroll
        for (int ni = 0; ni < 4; ++ni) {
            const int col = n0 + wc * 64 + ni * 16 + 4 * fq;
            const float4 g = *(const float4*)(gate + col);
#pragma unroll
            for (int mi = 0; mi < 4; ++mi) {
                const size_t o = (size_t)(m0 + wr * 64 + mi * 16 + l16) * 1024 + col;
                const float4 xv = *(const float4*)(xin + o);
                float4 r; r.x = xv.x + g.x * acc[mi][ni][0]; r.y = xv.y + g.y * acc[mi][ni][1]; r.z = xv.z + g.z * acc[mi][ni][2]; r.w = xv.w + g.w * acc[mi][ni][3];
                *(float4*)(p.out + o) = r;
            }
        }
    }
}

DI void cls_decode(int cls, int& e0, int& e1) {
    const int g = cls / 6, pi = cls % 6;
    const int lo = pi < 3 ? 0 : (pi < 5 ? 1 : 2);
    const int hi = pi < 3 ? pi + 1 : (pi < 5 ? pi - 1 : 3);
    e0 = g * 4 + lo; e1 = g * 4 + hi;
}
DI void phase_moe_gu(const Params& p, int layer, unsigned char* smem) {
    int* srow = (int*)(smem + GEMM_LDS);
    const int tid = otid(), lane = tid & 63, wave = tid >> 6, wr = wave >> 1, wc = wave & 1, l16 = lane & 15, fq = lane >> 4;
    const int* cnt = (const int*)(p.ws + OFF_CNT) + layer * 32;
    const u16* H = (const u16*)(p.ws + OFF_H);
    u16* HID = (u16*)(p.ws + OFF_HID);
    const float2* tokw = (const float2*)(p.ws + OFF_TOKW);
    int total = 0;
    for (int c = 0; c < NCLS; ++c) total += (cnt[c] + 127) >> 7;
    for (int r = 0;; ++r) {
        int it; if (!xcd_next(r, total * 8, it)) break;
        if (it >= total * 8) continue;
        int tile = it >> 3; const int slot = (it >> 2) & 1, nt = it & 3;
        int cls = 0;
        for (int c = 0; c < NCLS; ++c) { const int n = (cnt[c] + 127) >> 7; if (tile < n) { cls = c; break; } tile -= n; }
        const int nvalid = min(128, cnt[cls] - tile * 128);
        const int* list = (const int*)(p.ws + OFF_LIST) + (size_t)(layer * NCLS + cls) * NTOK + tile * 128;
        __syncthreads();
        if (tid < 128) srow[tid] = (tid < nvalid) ? list[tid] : -1;
        __syncthreads();
        int e0, e1; cls_decode(cls, e0, e1);
        const int ex = slot ? e1 : e0;
        size_t aoff[4], boff[4];
#pragma unroll
        for (int i = 0; i < 4; ++i) { const int rr = (wave * 4 + i) * 8 + ((tid >> 3) & 7); const int r = srow[rr]; aoff[i] = (size_t)(r < 0 ? 0 : r) * 1024; boff[i] = (size_t)rr * 1024; }
        f32x4 acc[4][4]; zero_acc(acc);
        gemm_core(tid, H, aoff, (const u16*)(p.ws + OFF_WGU) + ((size_t)(layer * 16 + ex) * 512 + nt * 128) * 1024, boff, 1024, smem, acc);
#pragma unroll
        for (int mi = 0; mi < 4; ++mi) {
            const int tok = srow[wr * 64 + mi * 16 + l16];
            if (tok < 0) continue;
            const float2 tw = tokw[tok];
            const float rw = slot ? tw.y : tw.x;
#pragma unroll
            for (int pr = 0; pr < 2; ++pr) {
                const f32x4 g = acc[mi][2 * pr], u = acc[mi][2 * pr + 1];
                float hv[4];
#pragma unroll
                for (int j = 0; j < 4; ++j) hv[j] = (g[j] / (1.f + __expf(-g[j]))) * u[j] * rw;
                const int hcol = nt * 64 + wc * 32 + pr * 16 + 4 * fq;
                uint2 pk; pk.x = pack2(hv[0], hv[1]); pk.y = pack2(hv[2], hv[3]);
                *(uint2*)(HID + ((size_t)tok * 2 + slot) * 256 + hcol) = pk;
            }
        }
    }
}
template <bool DUMMY> DI void phase_moe_down(const Params& p, int layer, unsigned char* smem) {
    int* srow = (int*)(smem + GEMM_LDS);
    const int tid = otid(), lane = tid & 63, wave = tid >> 6, wr = wave >> 1, wc = wave & 1, l16 = lane & 15, fq = lane >> 4;
    const int* cnt = (const int*)(p.ws + OFF_CNT) + layer * 32;
    const u16* HID = (const u16*)(p.ws + OFF_HID);
    const float* mod = (const float*)(p.ws + OFF_MOD);
    int total = 0;
    for (int c = 0; c < NCLS; ++c) total += (cnt[c] + 127) >> 7;
    for (int r = 0;; ++r) {
        int it; if (!xcd_next(r, total * 8, it)) break;
        if (it >= total * 8) continue;
        int tile = it >> 3; const int nt = it & 7;
        int cls = 0;
        for (int c = 0; c < NCLS; ++c) { const int n = (cnt[c] + 127) >> 7; if (tile < n) { cls = c; break; } tile -= n; }
        const int nvalid = min(128, cnt[cls] - tile * 128);
        const int* list = (const int*)(p.ws + OFF_LIST) + (size_t)(layer * NCLS + cls) * NTOK + tile * 128;
        __syncthreads();
        if (tid < 128) srow[tid] = (tid < nvalid) ? list[tid] : -1;
        __syncthreads();
        int e0, e1; cls_decode(cls, e0, e1);
        size_t aoff[4], boff[4];
#pragma unroll
        for (int i = 0; i < 4; ++i) { const int rr = (wave * 4 + i) * 8 + ((tid >> 3) & 7); const int r = srow[rr]; aoff[i] = (size_t)(r < 0 ? 0 : r) * 512; boff[i] = (size_t)rr * 256; }
        f32x4 acc[4][4]; zero_acc(acc);
        const u16* WD = (const u16*)(p.ws + OFF_WD);
        gemm_core(tid, HID, aoff, WD + ((size_t)(layer * 16 + e0) * 1024 + nt * 128) * 256, boff, 512, smem, acc,
                  HID + 256, WD + ((size_t)(layer * 16 + e1) * 1024 + nt * 128) * 256, 256);
#pragma unroll
        for (int mi = 0; mi < 4; ++mi) {
            const int tok = srow[wr * 64 + mi * 16 + l16];
            if (tok < 0) continue;
            const float* gate = mod + (size_t)(layer * 4 + (tok >> 12)) * 6144 + 5 * 1024;
#pragma unroll
            for (int ni = 0; ni < 4; ++ni) {
                const int col = nt * 128 + wc * 64 + ni * 16 + 4 * fq;
                const float4 g = *(const float4*)(gate + col);
                float* o = p.out + (size_t)tok * 1024 + col;
                float4 xv = *(const float4*)o;
                xv.x += g.x * acc[mi][ni][0]; xv.y += g.y * acc[mi][ni][1]; xv.z += g.z * acc[mi][ni][2]; xv.w += g.w * acc[mi][ni][3];
                if (DUMMY) o = (float*)(p.ws + OFF_PARK) + (((size_t)tok * 1024 + col) & 0x3FFFFFu);
                *(float4*)o = xv;
            }
        }
    }
}

DI void item_compress(const Params& p, int layer, int item, unsigned char* smem) {
    const int tid = otid();
    const int b = item >> 7, kv = (item >> 6) & 1, g = item & 63;
    float* xs = (float*)smem;
    float* part = xs + 80 * 64;
    float* hid = part + 1024;
    float* ob = hid + 256;
    const u16* Z = (const u16*)(p.ws + OFF_Z) + (size_t)(b * SEQ) * ZW + (kv ? ZC_VC : ZC_KC);
    const float* pe = p.cmp_pe + (size_t)(layer * 2 + kv) * 32 * 64;
    __syncthreads();
    for (int i = tid; i < 80 * 64; i += 256) { const int r = i >> 6, tk = 64 * g + r; xs[i] = (tk < SEQ) ? bf2f(Z[(size_t)tk * ZW + (i & 63)]) : 0.f; }
    __syncthreads();
    {
        const int q = tid >> 6, e = tid & 63;
        const float* w1 = p.w_cmp1 + (size_t)(layer * 2 + kv) * 32 * 64 * 64 + e;
        float a0 = 0.f, a1 = 0.f, a2 = 0.f, a3 = 0.f;
#pragma unroll 16
        for (int jd = q * 512; jd < q * 512 + 512; ++jd) {
            const float wv = w1[(size_t)jd * 64], pv = pe[jd];
            a0 += (xs[jd] + pv) * wv; a1 += (xs[1024 + jd] + pv) * wv; a2 += (xs[2048 + jd] + pv) * wv; a3 += (xs[3072 + jd] + pv) * wv;
        }
        part[(q * 4 + 0) * 64 + e] = a0; part[(q * 4 + 1) * 64 + e] = a1; part[(q * 4 + 2) * 64 + e] = a2; part[(q * 4 + 3) * 64 + e] = a3;
    }
    __syncthreads();
    const int nl = tid >> 6, e = tid & 63, n = 4 * g + nl;
    hid[nl * 64 + e] = gelu_tanh(part[(0 * 4 + nl) * 64 + e] + part[(1 * 4 + nl) * 64 + e] + part[(2 * 4 + nl) * 64 + e] + part[(3 * 4 + nl) * 64 + e]);
    __syncthreads();
    const float* w2 = p.w_cmp2 + (size_t)(layer * 2 + kv) * 64 * 64 + e;
    float o = 0.f;
#pragma unroll 8
    for (int k = 0; k < 64; ++k) o += hid[nl * 64 + k] * w2[(size_t)k * 64];
    ob[nl * 64 + e] = o;
    __syncthreads();
    if (kv == 0) {
        u16* kc = (u16*)(p.ws + OFF_KCMP) + ((size_t)b * 256 + n) * 64;
        if (n < 255) {
            float r = o;
            if (e < 16) {
                const int tk = b * SEQ + 16 * n + 16;
                const float2 cs = ((const float2*)(p.ws + OFF_ROPE))[(size_t)tk * 8 + (e & 7)];
                const float other = ob[nl * 64 + (e ^ 8)];
                r = (e < 8) ? o * cs.x - other * cs.y : o * cs.x + other * cs.y;
            }
            kc[e] = f2bf(r);
        } else kc[e] = 0;
    } else {
        u16* vt = (u16*)(p.ws + OFF_VCMPT) + ((size_t)b * 64 + e) * 256;
        vt[(n & ~15) | perm16(n & 15)] = (n < 255) ? f2bf(o) : (u16)0;
    }
}

constexpr int TK_CAP = 32;
constexpr int TK_CAPL = 256;
DI void item_topk(const Params& p, int item, unsigned char* smem) {
    const int tid = otid(), lane = tid & 63, wave = tid >> 6, ql = lane >> 4, l16 = lane & 15;
    const int b = item >> 8, t0b = (item & 255) * 16, t0 = t0b + wave * 4, t = t0 + ql;
    u32* hist = (u32*)(smem + wave * 14336);
    u32* histB = hist + 1024;
    u32* hist2 = histB + 1024;
    u16* mrow = (u16*)(hist2 + 1024);
    u32* cand = histB;
    u16* stg = (u16*)(smem + 57344);
    const u16* zb = (const u16*)(p.ws + OFF_Z) + (size_t)(b * SEQ) * ZW;
    const u16* ikc = (const u16*)(p.ws + OFF_IKC) + (size_t)(b * SEQ) * 32;
    u64* maskT = (u64*)(p.ws + OFF_MASK) + (size_t)b * 64 * SEQ;
    const int nchunk = (t0b + 15) / 128 + 1;
    bool chk = false;
    __syncthreads();
    if (t0b < 256) {
        for (int st = 0; st < 256; ++st) {
            if (l16 == 0) { const int k0 = st * 16; const int nb = t - k0 + 1; mrow[ql * 256 + st] = (u16)(nb >= 16 ? 0xffffu : (nb <= 0 ? 0u : ((1u << nb) - 1u))); }
        }
    } else {
        const bf16x8 afr = *(const bf16x8*)(zb + (size_t)(t0 + (l16 >> 2)) * ZW + ZC_IQ + (l16 & 3) * 32 + 8 * (lane >> 4));
        const float w0 = bf2f(zb[(size_t)t * ZW + ZC_IW + 0]), w1 = bf2f(zb[(size_t)t * ZW + ZC_IW + 1]), w2 = bf2f(zb[(size_t)t * ZW + ZC_IW + 2]), w3 = bf2f(zb[(size_t)t * ZW + ZC_IW + 3]);
        auto score_keys = [&](const u16* st, u32 (&key)[8]) {
#pragma unroll
            for (int i = 0; i < 8; ++i) {
                const bf16x8 bfr = *(const bf16x8*)(st + (i * 16 + l16) * 32 + 8 * (lane >> 4));
                const f32x4 a = MFMA16(afr, bfr, ((f32x4){0.f, 0.f, 0.f, 0.f}));
                const float r0 = __int_as_float(max(__float_as_int(a[0]), 0)), r1 = __int_as_float(max(__float_as_int(a[1]), 0)), r2 = __int_as_float(max(__float_as_int(a[2]), 0)), r3 = __int_as_float(max(__float_as_int(a[3]), 0));
                float s = w0 * r0;
                s = fmaf(w1, r1, s); s = fmaf(w2, r2, s); s = fmaf(w3, r3, s);
                s += 0.f;
                const u32 u = __float_as_uint(s);
                key[i] = u ^ ((u >> 31) ? 0xffffffffu : 0x80000000u);
            }
        };
#define TK_SWEEP_BEGIN(CST) \
        { u32x4 r0 = *(const u32x4*)(ikc + (size_t)tid * 8), r1 = *(const u32x4*)(ikc + 2048 + (size_t)tid * 8); \
          *(u32x4*)(stg + tid * 8) = r0; *(u32x4*)(stg + 2048 + tid * 8) = r1; \
          __syncthreads(); \
          int sidx = 0; \
          for (int c = 0; c < nchunk; c += (CST)) { \
              if (c + (CST) < nchunk) { const u16* g = ikc + (size_t)(c + (CST)) * 4096 + tid * 8; r0 = *(const u32x4*)(g); r1 = *(const u32x4*)(g + 2048); } \
              u32 key[8]; score_keys(stg + sidx * 4096, key);
#define TK_SWEEP_END(CST) \
              if (c + (CST) < nchunk) { u16* d = stg + (sidx ^ 1) * 4096 + tid * 8; *(u32x4*)(d) = r0; *(u32x4*)(d + 2048) = r1; } \
              sidx ^= 1; \
              __syncthreads(); \
          } }
        const int tl = t - l16;
        auto find_bin = [&](const u32* hrow, u32 want, u32& Bq, u32& aq, u32& cq, u32& total) {
            const u32* hq = hrow + 16 * l16;
            u32 sblk = 0;
#pragma unroll
            for (int i = 0; i < 16; ++i) sblk += hq[i];
            u32 v = sblk;
#pragma unroll
            for (int off = 1; off < 16; off <<= 1) { const u32 o = __shfl_down(v, off, 16); if (l16 + off < 16) v += o; }
            const u32 excl = v - sblk;
            total = __shfl(v, 16 * ql);
            const bool owner = (excl < want) && (want <= v);
            u32 Bo = 0, abo = 0, cdo = 0;
            if (owner) {
                u32 cum = excl; bool found = false;
                for (int i = 15; i >= 0; --i) { const u32 cn = hq[i]; if (!found && cum + cn >= want) { found = true; Bo = 16 * l16 + i; abo = cum; cdo = cn; } if (!found) cum += cn; }
            }
            const u64 om = __ballot(owner);
            const int srcl = 16 * ql + __builtin_ctz((u32)((om >> (16 * ql)) & 0xffffu) | 0x10000u);
            Bq = __shfl(Bo, srcl); aq = __shfl(abo, srcl); cq = __shfl(cdo, srcl);
        };
        bool listed = false;
        if (nchunk >= 16) {
#pragma unroll
            for (int i = 0; i < 16; ++i) hist[lane + 64 * i] = 0;
            wave_lds_fence();
            TK_SWEEP_BEGIN(4)
#pragma unroll
                for (int i = 0; i < 8; ++i) if ((c * 128 + i * 16) <= tl) atomicAdd(&hist[ql * 256 + (key[i] >> 24)], 1u);
            TK_SWEEP_END(4)
            wave_lds_fence();
            u32 Bh, Bl, ah, al, c_, tot;
            u32 tsum = 0;
            { const u32* hq = hist + ql * 256 + 16 * l16; u32 sb = 0;
#pragma unroll
              for (int i = 0; i < 16; ++i) sb += hq[i];
#pragma unroll
              for (int off = 1; off < 16; off <<= 1) sb += __shfl_xor(sb, off);
              tsum = sb; }
            const u32 rs = (256u * tsum) / (u32)(t + 1);
            const u32 r_hi = rs > 25u ? rs - 24u : 1u, r_lo = min(tsum, rs + 24u);
            find_bin(hist + ql * 256, r_hi, Bh, ah, c_, tot);
            find_bin(hist + ql * 256, r_lo, Bl, al, c_, tot);
            const int bad = block_or((Bh - Bl > 1u) ? 1 : 0, smem);
            if (!bad) {
#pragma unroll
                for (int i = 0; i < 32; ++i) hist[lane + 64 * i] = 0;
                wave_lds_fence();
                TK_SWEEP_BEGIN(4)
#pragma unroll
                    for (int i = 0; i < 8; ++i) {
                        const bool valid = (c * 128 + i * 16) <= tl;
                        const u32 tb = key[i] >> 24;
                        if (valid & ((tb == Bh) | (tb == Bl))) atomicAdd(&hist[(tb == Bh ? 0 : 1024) + ql * 256 + ((key[i] >> 16) & 255u)], 1u);
                    }
                TK_SWEEP_END(4)
                wave_lds_fence();
                u32 b2h, b2l, a_;
                find_bin(hist + ql * 256, r_hi - ah, b2h, a_, c_, tot);
                find_bin((Bl == Bh ? hist : histB) + ql * 256, r_lo - al, b2l, a_, c_, tot);
                const u32 hi16 = (Bh << 8) | b2h, lo16 = (Bl << 8) | b2l;
                wave_lds_fence();
                u32* lst = hist;
                int ca = 0, cnt = 0;
                TK_SWEEP_BEGIN(1)
#pragma unroll
                    for (int i = 0; i < 8; ++i) {
                        const int st = c * 8 + i;
                        const bool valid = (st * 16) <= tl;
                        const u32 k16 = key[i] >> 16;
                        const bool above = valid & (k16 > hi16);
                        const bool cd = valid & (k16 >= lo16) & !above;
                        ca += above ? 1 : 0;
                        const u64 cb = __ballot(cd);
                        const u32 seg = (u32)((cb >> (16 * ql)) & 0xffffu);
                        const int pos = cnt + __popc(seg & ((1u << l16) - 1u));
                        if (cd && pos < TK_CAPL) { lst[(ql * TK_CAPL + pos) * 2] = key[i]; lst[(ql * TK_CAPL + pos) * 2 + 1] = (u32)(st * 16 + l16); }
                        cnt += __popc(seg);
                        const u64 sb = __ballot(above);
                        if (l16 == 0) mrow[ql * 256 + st] = (u16)((sb >> (16 * ql)) & 0xffffu);
                    }
                TK_SWEEP_END(1)
                for (int st = nchunk * 8 + (lane & 15); st < 256; st += 16) mrow[ql * 256 + st] = 0;
#pragma unroll
                for (int off = 1; off < 16; off <<= 1) ca += __shfl_xor(ca, off);
                const bool ok = (ca < 256) && (256 <= ca + cnt) && (cnt <= TK_CAPL);
                const int miss = block_or(ok ? 0 : 1, smem);
                if (!miss) {
                    listed = true;
                    wave_lds_fence();
                    int need2 = 256 - ca;
                    int ncmax = cnt;
#pragma unroll
                    for (int off = 16; off < 64; off <<= 1) ncmax = max(ncmax, __shfl_xor(ncmax, off));
                    u32 pfx = 0;
#pragma unroll 1
                    for (int lv = 0; lv < 4; ++lv) {
                        const int sh = 24 - 8 * lv;
#pragma unroll
                        for (int i = 0; i < 16; ++i) hist2[lane + 64 * i] = 0;
                        wave_lds_fence();
                        for (int e = l16; e < ncmax; e += 16) {
                            if (e < cnt) {
                                const u32 k = lst[(ql * TK_CAPL + e) * 2];
                                if ((u32)((u64)k >> (sh + 8)) == pfx) atomicAdd(&hist2[ql * 256 + ((k >> sh) & 255u)], 1u);
                            }
                        }
                        wave_lds_fence();
                        u32 Bq, aq, cq, tt;
                        find_bin(hist2 + ql * 256, (u32)need2, Bq, aq, cq, tt);
                        pfx = (pfx << 8) | Bq; need2 -= (int)aq;
                    }
                    int run = 0;
                    for (int base = 0; base < ncmax; base += 16) {
                        const int e = base + l16;
                        const bool v = e < cnt;
                        const u32 k = v ? lst[(ql * TK_CAPL + e) * 2] : 0u, idx = v ? lst[(ql * TK_CAPL + e) * 2 + 1] : 0u;
                        const bool eq = v && (k == pfx);
                        const u64 eb = __ballot(eq);
                        const u32 seg = (u32)((eb >> (16 * ql)) & 0xffffu);
                        const bool sel = (v && k > pfx) || (eq && (run + __popc(seg & ((1u << l16) - 1u))) < need2);
                        run += __popc(seg);
                        if (sel) atomicOr((u32*)(mrow + ql * 256) + (idx >> 5), 1u << (idx & 31));
                    }
                }
            }
        }
#if TKCHECK
        chk = listed;
        if (listed) { wave_lds_fence(); const u64* m64c = (const u64*)mrow;
            for (int qq = 0; qq < 4; ++qq) maskT[(size_t)lane * SEQ + t0 + qq] = m64c[qq * 64 + lane];
            wave_lds_fence(); atomicAdd((int*)(p.ws + OFF_CNT) + 101, 1); }
        __syncthreads();
#endif
        if (!listed || TKCHECK) {
        u32 prefix = 0; int need = 256; int shift = 32, shift_prev = 32; int lvl = 0;
        for (;;) {
            shift = 24 - 8 * lvl;
#pragma unroll
            for (int i = 0; i < 16; ++i) hist[lane + 64 * i] = 0;
            wave_lds_fence();
            TK_SWEEP_BEGIN(1)
#pragma unroll
                for (int i = 0; i < 8; ++i) {
                    const bool match = ((c * 128 + i * 16) <= tl) & ((u32)((u64)key[i] >> shift_prev) == prefix);
                    if (match) atomicAdd(&hist[ql * 256 + ((key[i] >> shift) & 255u)], 1u);
                }
            TK_SWEEP_END(1)
            wave_lds_fence();
            u32 Bq, aq, cq, tot;
            find_bin(hist + ql * 256, (u32)need, Bq, aq, cq, tot);
            prefix = (prefix << 8) | Bq; need -= (int)aq;
            const int more = block_or((lvl < 3 && cq > (u32)TK_CAP) ? 1 : 0, smem);
            if (!more) break;
            ++lvl; shift_prev = shift;
        }
        const bool exact = (lvl == 3);
        int run = 0, ccount = 0;
        TK_SWEEP_BEGIN(1)
#pragma unroll
            for (int i = 0; i < 8; ++i) {
                const int st = c * 8 + i;
                const bool valid = (st * 16) <= tl;
                const u32 kp = exact ? key[i] : (key[i] >> shift);
                const bool hi = valid && kp > prefix, cd = valid && kp == prefix;
                const u64 cb = __ballot(cd);
                const u32 seg = (u32)((cb >> (16 * ql)) & 0xffffu);
                const int below = __popc(seg & ((1u << l16) - 1u));
                bool sel = hi;
                if (exact) { sel = hi || (cd && (run + below) < need); run += __popc(seg); }
                else { if (cd) { const int pos = ccount + below; if (pos < TK_CAP) { cand[(ql * TK_CAP + pos) * 2] = key[i]; cand[(ql * TK_CAP + pos) * 2 + 1] = (u32)(st * 16 + l16); } } ccount += __popc(seg); }
                const u64 sb = __ballot(sel);
                if (l16 == 0) mrow[ql * 256 + st] = (u16)((sb >> (16 * ql)) & 0xffffu);
            }
        TK_SWEEP_END(1)
        for (int st = nchunk * 8 + (lane & 15); st < 256; st += 16) mrow[ql * 256 + st] = 0;
        wave_lds_fence();
        if (!exact) {
            const int n = min(ccount, TK_CAP);
            for (int c = l16; c < n; c += 16) {
                const u32 k = cand[(ql * TK_CAP + c) * 2], idx = cand[(ql * TK_CAP + c) * 2 + 1];
                int rank = 0;
                for (int c2 = 0; c2 < n; ++c2) { const u32 k2 = cand[(ql * TK_CAP + c2) * 2]; rank += (k2 > k || (k2 == k && c2 < c)) ? 1 : 0; }
                if (rank < need) atomicOr((u32*)(mrow + ql * 256) + (idx >> 5), 1u << (idx & 31));
            }
        }
        }
    }
    wave_lds_fence();
    const u64* m64 = (const u64*)mrow;
#if TKCHECK
    if (chk) { bool diff = false;
        for (int qq = 0; qq < 4; ++qq) diff |= maskT[(size_t)lane * SEQ + t0 + qq] != m64[qq * 64 + lane];
        if (diff) atomicOr((int*)(p.ws + OFF_CNT) + 100, 1); }
#endif
#pragma unroll
    for (int qq = 0; qq < 4; ++qq) maskT[(size_t)lane * SEQ + t0 + qq] = m64[qq * 64 + lane];
    wave_lds_fence();
}

DI void item_gmlp(const Params& p, int layer, int item, unsigned char* smem) {
    const int tid = otid(), lane = tid & 63, wave = tid >> 6, l16 = lane & 15, fq = lane >> 4;
    const int T0 = item * 128;
    u16* vnT = (u16*)smem;
    float2* stat = (float2*)(smem + 2 * 64 * 136 * 2);
    const u16* Z = (const u16*)(p.ws + OFF_Z);
    u16* CC = (u16*)(p.ws + OFF_CONCAT);
    __syncthreads();
    {
        const int s = tid >> 1, half = tid & 1;
        const uint4* src = (const uint4*)(Z + (size_t)(T0 + s) * ZW + ZC_BV + 128 * half);
        float sm = 0.f, sq = 0.f;
#pragma unroll
        for (int i = 0; i < 16; ++i) { const uint4 q = src[i]; const u32 w[4] = {q.x, q.y, q.z, q.w};
#pragma unroll
            for (int j = 0; j < 4; ++j) { const float a = __uint_as_float(w[j] << 16), c = __uint_as_float(w[j] & 0xffff0000u); sm += a + c; sq += a * a + c * c; } }
        sm += __shfl_xor(sm, 1); sq += __shfl_xor(sq, 1);
        const float mu = sm * (1.f / 256.f), var = fmaxf(sq * (1.f / 256.f) - mu * mu, 0.f);
        if (half == 0) { float2 st; st.x = mu; st.y = rsqrtf(var + 1e-6f); stat[s] = st; }
    }
    __syncthreads();
    const u16* WS = (const u16*)(p.ws + OFF_WSGU) + (size_t)layer * 4 * 128 * 128;
    for (int rd = 0; rd < 2; ++rd) {
        for (int i = tid; i < 128 * 16; i += 256) {
            const int s = i >> 4, c8 = (i & 15) * 8, ch = rd * 128 + c8;
            const uint4 q = *(const uint4*)(Z + (size_t)(T0 + s) * ZW + ZC_BV + ch);
            const float2 st = stat[s];
            const u32 w[4] = {q.x, q.y, q.z, q.w};
#pragma unroll
            for (int j = 0; j < 4; ++j) {
                const float a = __uint_as_float(w[j] << 16), c = __uint_as_float(w[j] & 0xffff0000u);
                const float g0 = p.sgu_g[layer * 256 + ch + 2 * j], g1 = p.sgu_g[layer * 256 + ch + 2 * j + 1];
                vnT[(size_t)(c8 + 2 * j) * 136 + s] = f2bf((a - st.x) * st.y * g0);
                vnT[(size_t)(c8 + 2 * j + 1) * 136 + s] = f2bf((c - st.x) * st.y * g1);
            }
        }
        __syncthreads();
        const int hh = wave & 1, th = wave >> 1, hd = 2 * rd + hh;
        f32x4 acc[4][4]; zero_acc(acc);
        const u16* Wh = WS + (size_t)hd * 128 * 128;
#pragma unroll
        for (int ti = 0; ti < 4; ++ti) {
            const int tb = 64 * th + 16 * ti;
            bf16x8 wf[4];
#pragma unroll
            for (int ks = 0; ks < 4; ++ks) wf[ks] = *(const bf16x8*)(Wh + (size_t)(tb + l16) * 128 + ks * 32 + 8 * fq);
#pragma unroll
            for (int ks = 0; ks < 4; ++ks) {
                if (ks * 32 >= tb + 16) continue;
#pragma unroll
                for (int di = 0; di < 4; ++di) {
                    const bf16x8 vf = *(const bf16x8*)(vnT + (size_t)(hh * 64 + di * 16 + l16) * 136 + ks * 32 + 8 * fq);
                    acc[ti][di] = MFMA16(vf, wf[ks], acc[ti][di]);
                }
            }
        }
#pragma unroll
        for (int ti = 0; ti < 4; ++ti) {
            const int tl = 64 * th + 16 * ti + l16;
            const float bias = p.b_sgu[(size_t)(layer * 4 + hd) * 128 + tl];
#pragma unroll
            for (int di = 0; di < 4; ++di) {
                const int d = di * 16 + 4 * fq;
                const uint2 uq = *(const uint2*)(Z + (size_t)(T0 + tl) * ZW + ZC_BU + hd * 64 + d);
                const float u0 = __uint_as_float(uq.x << 16), u1 = __uint_as_float(uq.x & 0xffff0000u), u2 = __uint_as_float(uq.y << 16), u3 = __uint_as_float(uq.y & 0xffff0000u);
                uint2 pk; pk.x = pack2(u0 * (acc[ti][di][0] + bias), u1 * (acc[ti][di][1] + bias)); pk.y = pack2(u2 * (acc[ti][di][2] + bias), u3 * (acc[ti][di][3] + bias));
                *(uint2*)(CC + (size_t)(T0 + tl) * 1024 + 256 + hd * 64 + d) = pk;
            }
        }
        __syncthreads();
    }
}

DI void item_pool(const Params& p, int layer, int item, unsigned char* smem) {
    const int tid = otid();
    const int T0 = item * 64, tseq0 = T0 & 4095;
    float* zt = (float*)smem;
    float* P = zt + 79 * 64;
    float* wl = zt;
    const u16* Z = (const u16*)(p.ws + OFF_Z);
    u16* CC = (u16*)(p.ws + OFF_CONCAT);
    for (int g = 0; g < 4; ++g) {
        const int w = 2 << g;
        __syncthreads();
        for (int i = tid; i < 79 * 8; i += 256) {
            const int r = i >> 3, c8 = (i & 7) * 8, ts = tseq0 - 15 + r;
            u32x4 q = {0u, 0u, 0u, 0u};
            if (ts >= 0) q = *(const u32x4*)(Z + (size_t)(T0 - 15 + r) * ZW + ZC_CZ + g * 64 + c8);
#pragma unroll
            for (int j = 0; j < 4; ++j) { zt[r * 64 + c8 + 2 * j] = __uint_as_float(q[j] << 16); zt[r * 64 + c8 + 2 * j + 1] = __uint_as_float(q[j] & 0xffff0000u); }
        }
        f32x4 wreg[4];
        {
            const f32x4* wsrc = (const f32x4*)(p.w_pool + (size_t)(layer * 4 + g) * 64 * 64);
#pragma unroll
            for (int i = 0; i < 4; ++i) wreg[i] = wsrc[tid + 256 * i];
        }
        __syncthreads();
        for (int i = tid; i < 64 * 64; i += 256) {
            const int tl = i >> 6, c = i & 63, ts = tseq0 + tl;
            const int lo = max(ts + 1 - w, 0), cntw = ts + 1 - lo;
            float sacc = 0.f;
            for (int k = 0; k < cntw; ++k) sacc += zt[(tl + 15 - k) * 64 + c];
            P[tl * 65 + c] = sacc / (float)cntw - zt[(tl + 15) * 64 + c];
        }
        __syncthreads();
#pragma unroll
        for (int i = 0; i < 4; ++i) ((f32x4*)wl)[tid + 256 * i] = wreg[i];
        __syncthreads();
        const int e = tid & 63, tg = tid >> 6;
        float acc[16];
#pragma unroll
        for (int i = 0; i < 16; ++i) acc[i] = 0.f;
#pragma unroll 4
        for (int c = 0; c < 64; ++c) {
            const float wv = wl[c * 64 + e];
#pragma unroll
            for (int i = 0; i < 16; ++i) acc[i] += P[(tg * 16 + i) * 65 + c] * wv;
        }
        const float sc = p.pool_scale[layer * 256 + g * 64 + e];
#pragma unroll
        for (int i = 0; i < 16; ++i) CC[(size_t)(T0 + tg * 16 + i) * 1024 + 512 + g * 64 + e] = f2bf(acc[i] * sc);
    }
}

constexpr int P2A_CMP = 512, P2A_TOPK = 1024, P2A_GMLP = 128, P2A_POOL = 256;
#ifndef REP2
#define REP2 0
#endif
DI int next_item(int* ctr, unsigned char* smem) {
    volatile int* slot = (volatile int*)(smem + SMEM_BYTES - 16);
    __syncthreads();
    if (threadIdx.x == 0) *slot = atomicAdd(ctr, 1);
    __syncthreads();
    return *slot;
}
DI void phase_mix_a(const Params& p, int layer, unsigned char* smem) {
    const int nwt = (layer == 0) ? WT_DEFER : 0;
    const int total = P2A_CMP + P2A_TOPK + P2A_GMLP + P2A_POOL + nwt;
    int* ctr = (int*)(p.ws + OFF_CNT) + 64 + layer * 2;
    for (;;) {
        int it = next_item(ctr, smem);
        if (it >= total) break;
        if (it < P2A_GMLP) {
#pragma unroll 1
            for (int rep = 0; rep < 1 + ((REP2 >> 2) & 1); ++rep) item_gmlp(p, layer, it, smem);
        } else if ((it -= P2A_GMLP) < P2A_POOL) {
#pragma unroll 1
            for (int rep = 0; rep < 1 + ((REP2 >> 3) & 1); ++rep) item_pool(p, layer, it, smem);
        } else if ((it -= P2A_POOL) < P2A_CMP) {
#pragma unroll 1
            for (int rep = 0; rep < 1 + ((REP2 >> 1) & 1); ++rep) item_compress(p, layer, it, smem);
        } else if ((it -= P2A_CMP) < nwt) {
            const int tidw = otid();
#pragma unroll 1
            for (int k = 0; k < 8; ++k) wtile(p, P0_NOW + it * 8 + k, smem, tidw);
        } else {
            it -= nwt;
            const int b = it & 3, g = 255 - (it >> 2);
#pragma unroll 1
            for (int rep = 0; rep < 1 + (REP2 & 1); ++rep) item_topk(p, b * 256 + g, smem);
        }
    }
}

constexpr float LOG2E = 1.4426950408889634f;
constexpr int SROW = 72;
constexpr int STAGE_U16 = 2 * 64 * SROW;
struct TileRegs { u32x4 k0, k1, v0, v1; };
DI void tile_fetch(TileRegs& r, int tid, const u16* __restrict__ Kt, int kld, const u16* __restrict__ Vt, int vld) {
    const int row = tid >> 3, ch = (tid & 7) * 8;
    r.k0 = *(const u32x4*)(Kt + (size_t)row * kld + ch); r.k1 = *(const u32x4*)(Kt + (size_t)(row + 32) * kld + ch);
    r.v0 = *(const u32x4*)(Vt + (size_t)row * vld + ch); r.v1 = *(const u32x4*)(Vt + (size_t)(row + 32) * vld + ch);
}
DI void tile_store(const TileRegs& r, int tid, u16* st) {
    const int row = tid >> 3, ch = (tid & 7) * 8;
    *(u32x4*)(st + row * SROW + ch) = r.k0; *(u32x4*)(st + (row + 32) * SROW + ch) = r.k1;
    *(u32x4*)(st + 64 * SROW + row * SROW + ch) = r.v0; *(u32x4*)(st + 64 * SROW + (row + 32) * SROW + ch) = r.v1;
}
template <class MaskF>
DI void flash_tile(const int lane, const u16* st, const bf16x8 (&qf)[4], f32x16& O0, f32x16& O1, float& m, float& l, MaskF maskf) {
    const int r31 = lane & 31, h = lane >> 5;
    const u16* sK = st + r31 * SROW + 8 * h; const u16* sV = st + 64 * SROW + r31 * SROW + 8 * h;
    f32x16 S0, S1;
#pragma unroll
    for (int i = 0; i < 16; ++i) { S0[i] = 0.f; S1[i] = 0.f; }
#pragma unroll
    for (int kk = 0; kk < 4; ++kk) {
        const bf16x8 k0f = *(const bf16x8*)(sK + kk * 16);
        const bf16x8 k1f = *(const bf16x8*)(sK + 32 * SROW + kk * 16);
        S0 = MFMA32(k0f, qf[kk], S0); S1 = MFMA32(k1f, qf[kk], S1);
    }
    asm volatile("" ::: "memory");
    float mx = -INFINITY;
#pragma unroll
    for (int r = 0; r < 16; ++r) {
        const int c = (r & 3) + 8 * (r >> 2);
        S0[r] = maskf(0, c, S0[r]);
        S1[r] = maskf(1, c, S1[r]);
        mx = fmaxf(mx, fmaxf(S0[r], S1[r]));
    }
    mx = fmaxf(mx, __shfl_xor(mx, 32));
    const float mnew = fmaxf(m, mx);
    float ps = 0.f;
#pragma unroll
    for (int r = 0; r < 16; ++r) {
        const float p0 = __builtin_amdgcn_exp2f(S0[r] - mnew), p1 = __builtin_amdgcn_exp2f(S1[r] - mnew);
        S0[r] = p0; S1[r] = p1; ps += p0 + p1;
    }
    if (__ballot(mnew > m) != 0) {
        const float alpha = __builtin_amdgcn_exp2f(m - mnew);
        l *= alpha;
#pragma unroll
        for (int i = 0; i < 16; ++i) { O0[i] *= alpha; O1[i] *= alpha; }
    }
    m = mnew;
    l += ps;
#pragma unroll
    for (int G = 0; G < 4; ++G) {
        u32x4 pw;
#pragma unroll
        for (int j = 0; j < 4; ++j) {
            const int r = (G & 1) * 8 + 2 * j;
            pw[j] = (G < 2) ? pack2(S0[r], S0[r + 1]) : pack2(S1[r], S1[r + 1]);
        }
        const bf16x8 pfv = __builtin_bit_cast(bf16x8, pw);
        const bf16x8 v0 = *(const bf16x8*)(sV + 16 * G);
        const bf16x8 v1 = *(const bf16x8*)(sV + 32 * SROW + 16 * G);
        O0 = MFMA32(v0, pfv, O0); O1 = MFMA32(v1, pfv, O1);
    }
}
DI void load_q(const u16* qrow, bf16x8 (&qf)[4]) {
#pragma unroll
    for (int kk = 0; kk < 4; ++kk) {
        bf16x8 t = *(const bf16x8*)(qrow + kk * 16);
#pragma unroll
        for (int j = 0; j < 8; ++j) t[j] = (short)f2bf(bf2f((u16)t[j]) * (0.125f * LOG2E));
        qf[kk] = t;
    }
}
DI void zero16(f32x16& a) {
#pragma unroll
    for (int i = 0; i < 16; ++i) a[i] = 0.f;
}
DI void store_o(u16* orow, const f32x16& O0, const f32x16& O1, int h) {
#pragma unroll
    for (int i = 0; i < 4; ++i) {
        uint2 a; a.x = pack2(O0[4 * i], O0[4 * i + 1]); a.y = pack2(O0[4 * i + 2], O0[4 * i + 3]);
        *(uint2*)(orow + 8 * i + 4 * h) = a;
        uint2 c; c.x = pack2(O1[4 * i], O1[4 * i + 1]); c.y = pack2(O1[4 * i + 2], O1[4 * i + 3]);
        *(uint2*)(orow + 32 + 8 * i + 4 * h) = c;
    }
}

DI void item_dsa_attn(const Params& p, int item, unsigned char* smem) {
    const int tid = otid(); const int lane = tid & 63, wave = tid >> 6, r31 = lane & 31, h = lane >> 5;
    const int b = item >> 7, hd = (item >> 5) & 3, qb = (item & 31) * 128, q0 = qb + wave * 32;
    u16* stg = (u16*)smem;
    const u16* Z = (const u16*)(p.ws + OFF_Z) + (size_t)(b * SEQ) * ZW;
    const u16* Kb = Z + ZC_AK + hd * 64;
    const u16* Vt = (const u16*)(p.ws + OFF_VTA) + (size_t)(b * 4 + hd) * 64 * SEQ;
    const u64* maskT = (const u64*)(p.ws + OFF_MASK) + (size_t)b * 64 * SEQ + q0 + r31;
    bf16x8 qf[4]; load_q(Z + (size_t)(q0 + r31) * ZW + ZC_AQ + hd * 64 + 8 * h, qf);
    f32x16 O0, O1; zero16(O0); zero16(O1); float m = -1e30f, l = 0.f;
    const int ntile = (qb + 127) / 64 + 1;
    TileRegs tr;
    __syncthreads();
    tile_fetch(tr, tid, Kb, ZW, Vt, SEQ);
    u64 wn = maskT[0];
    tile_store(tr, tid, stg);
    __syncthreads();
    for (int j = 0; j < ntile; ++j) {
        const u64 w = wn;
        if (j + 1 < ntile) { tile_fetch(tr, tid, Kb + (size_t)((j + 1) * 64) * ZW, ZW, Vt + (j + 1) * 64, SEQ); wn = maskT[(size_t)(j + 1) * SEQ]; }
        if (__ballot(w != 0) != 0) {
            const u32 wl = (u32)(w >> (4 * h)), wh = (u32)(w >> (32 + 4 * h));
            flash_tile(lane, stg + (j & 1) * STAGE_U16, qf, O0, O1, m, l, [&](int kb, int c, float sv) { const u32 mk = (u32)__builtin_amdgcn_sbfe((int)(kb ? wh : wl), c, 1); return __uint_as_float((__float_as_uint(sv) & mk) | (0xff800000u & ~mk)); });
        }
        if (j + 1 < ntile) tile_store(tr, tid, stg + ((j + 1) & 1) * STAGE_U16);
        __syncthreads();
    }
    const float lt = l + __shfl_xor(l, 32);
    const float inv = lt > 0.f ? 1.f / lt : 0.f;
#pragma unroll
    for (int i = 0; i < 16; ++i) { O0[i] *= inv; O1[i] *= inv; }
    store_o((u16*)(p.ws + OFF_CONCAT) + (size_t)(b * SEQ + q0 + r31) * 1024 + hd * 64, O0, O1, h);
}

DI void item_nsa(const Params& p, int item, unsigned char* smem) {
    const int tid = otid(), lane = tid & 63, hd = tid >> 6, r31 = lane & 31, h = lane >> 5;
    const int b = item >> 7, q0 = (item & 127) * 32, t = q0 + r31;
    u16* stg = (u16*)smem;
    float* impP = (float*)smem;
    float* impS = (float*)(smem + 36864);
    u64* selm = (u64*)(smem + 36864 + 8448);
    u32* Uw = (u32*)(smem + 36864 + 8448 + 256);
    const u16* Z = (const u16*)(p.ws + OFF_Z) + (size_t)(b * SEQ) * ZW;
    bf16x8 qf[4]; load_q(Z + (size_t)t * ZW + ZC_DQ + hd * 64 + 8 * h, qf);
    float gt[3];
#pragma unroll
    for (int i = 0; i < 3; ++i) gt[i] = sigmoidf_(bf2f(Z[(size_t)t * ZW + ZC_DG + hd * 3 + i]));
    float* park = (float*)(p.ws + OFF_PARK) + (size_t)blockIdx.x * 32 * 256 + tid;
    f32x16 O0, O1; float m, l;
    TileRegs tr;
    const u16* KC = (const u16*)(p.ws + OFF_KCMP) + (size_t)b * 256 * 64;
    const u16* VC = (const u16*)(p.ws + OFF_VCMPT) + (size_t)b * 64 * 256;
    zero16(O0); zero16(O1); m = -1e30f; l = 0.f;
    const int ntc = min(4, q0 / 1024 + 1);
    const int nmax = (t >= 31) ? min(254, (t - 31) >> 4) : -1;
    const int nmax_lo = (q0 >= 31) ? min(254, (q0 - 31) >> 4) : -1;
    __syncthreads();
    if (tid < 2) Uw[tid] = 0;
    tile_fetch(tr, tid, KC, 64, VC, 256);
    tile_store(tr, tid, stg);
    __syncthreads();
    for (int T = 0; T < ntc; ++T) {
        if (T + 1 < ntc) tile_fetch(tr, tid, KC + (size_t)((T + 1) * 64) * 64, 64, VC + (T + 1) * 64, 256);
        const int lim = nmax - T * 64 - 4 * h;
        flash_tile(lane, stg + (T & 1) * STAGE_U16, qf, O0, O1, m, l, [&](int kb, int c, float sv) { return ((32 * kb + c) <= lim) ? sv : -INFINITY; });
        if (T + 1 < ntc) tile_store(tr, tid, stg + ((T + 1) & 1) * STAGE_U16);
        __syncthreads();
    }
    {
        const float lt = l + __shfl_xor(l, 32);
        const float inv = lt > 0.f ? 1.f / lt : 0.f;
#pragma unroll
        for (int i = 0; i < 16; ++i) { park[i * 256] = gt[0] * inv * O0[i]; park[(16 + i) * 256] = gt[0] * inv * O1[i]; }
        float prev_c = 0.f;
        for (int T = 0; T < 4; ++T) {
            f32x16 S0, S1; zero16(S0); zero16(S1);
            if (T < ntc) {
#pragma unroll
                for (int kk = 0; kk < 4; ++kk) {
                    const bf16x8 k0f = *(const bf16x8*)(KC + (size_t)(T * 64 + r31) * 64 + kk * 16 + 8 * h);
                    const bf16x8 k1f = *(const bf16x8*)(KC + (size_t)(T * 64 + 32 + r31) * 64 + kk * 16 + 8 * h);
                    S0 = MFMA32(k0f, qf[kk], S0); S1 = MFMA32(k1f, qf[kk], S1);
                }
            }
#pragma unroll
            for (int kb = 0; kb < 2; ++kb)
#pragma unroll
                for (int i = 0; i < 4; ++i) {
                    float pv[4];
#pragma unroll
                    for (int k = 0; k < 4; ++k) {
                        const int n = T * 64 + kb * 32 + 8 * i + 4 * h + k;
                        const float s = kb ? S1[4 * i + k] : S0[4 * i + k];
                        pv[k] = (T < ntc && n <= nmax) ? __builtin_amdgcn_exp2f(s - m) * inv : 0.f;
                    }
                    float a = pv[0] + pv[1] + pv[2] + 0.5f * pv[3];
                    const float c = 0.5f * pv[3];
                    const float recv = __shfl_xor(h ? prev_c : c, 32);
                    a += recv; prev_c = c;
                    impP[(hd * 32 + r31) * 64 + 16 * T + 8 * kb + 2 * i + h] = a;
                }
        }
    }
    __syncthreads();
    {
        const int q = tid >> 3, part = tid & 7, tq = q0 + q, curb = tq >> 6;
#pragma unroll
        for (int jj = 0; jj < 8; ++jj) {
            const int j = part * 8 + jj;
            float v = impP[(0 * 32 + q) * 64 + j] + impP[(1 * 32 + q) * 64 + j] + impP[(2 * 32 + q) * 64 + j] + impP[(3 * 32 + q) * 64 + j];
            if (j == curb || j == 0) v = INFINITY;
            if (64 * j > tq) v = -INFINITY;
            impS[q * 65 + j] = v;
        }
        __syncthreads();
        u32 bits = 0;
#pragma unroll
        for (int jj = 0; jj < 8; ++jj) {
            const int j = part * 8 + jj; const float v = impS[q * 65 + j];
            int rank = 0;
            for (int j2 = 0; j2 < 64; ++j2) { const float v2 = impS[q * 65 + j2]; rank += (v2 > v || (v2 == v && j2 < j)) ? 1 : 0; }
            if (rank < 16 && 64 * j <= tq) bits |= 1u << jj;
        }
        u64 w = (u64)bits << (8 * part);
        w |= __shfl_xor(w, 1); w |= __shfl_xor(w, 2); w |= __shfl_xor(w, 4);
        if (part == 0) { selm[q] = w; atomicOr(&Uw[0], (u32)w); atomicOr(&Uw[1], (u32)(w >> 32)); }
    }
    __syncthreads();
    const int cur = q0 >> 6;
    {
        const u64 sw = selm[r31];
        u64 U = (u64)Uw[0] | ((u64)Uw[1] << 32);
        const u16* Kb = Z + ZC_KS;
        const u16* Vt = (const u16*)(p.ws + OFF_VTS) + (size_t)b * 64 * SEQ;
        zero16(O0); zero16(O1); m = -1e30f; l = 0.f;
        int j = __builtin_ctzll(U); U &= U - 1;
        tile_fetch(tr, tid, Kb + (size_t)(j * 64) * ZW, ZW, Vt + j * 64, SEQ);
        tile_store(tr, tid, stg);
        __syncthreads();
        for (int i = 0;; ++i) {
            const int jn = U ? __builtin_ctzll(U) : -1; U &= U - 1;
            if (jn >= 0) tile_fetch(tr, tid, Kb + (size_t)(jn * 64) * ZW, ZW, Vt + jn * 64, SEQ);
            const bool bit = ((sw >> j) & 1ull) != 0;
            const int key0 = j * 64;
            const int lim = t - key0 - 4 * h;
            if (__ballot(bit) != 0) {
                if (j < cur) { const float rb = bit ? 0.f : -INFINITY; flash_tile(lane, stg + (i & 1) * STAGE_U16, qf, O0, O1, m, l, [&](int kb, int c, float sv) { return sv + rb; }); }
                else flash_tile(lane, stg + (i & 1) * STAGE_U16, qf, O0, O1, m, l, [&](int kb, int c, float sv) { return (bit && ((32 * kb + c) <= lim)) ? sv : -INFINITY; });
            }
            if (jn >= 0) tile_store(tr, tid, stg + ((i + 1) & 1) * STAGE_U16);
            __syncthreads();
            if (jn < 0) break;
            j = jn;
        }
        const float lt = l + __shfl_xor(l, 32);
        const float inv = lt > 0.f ? 1.f / lt : 0.f;
#pragma unroll
        for (int i = 0; i < 16; ++i) { park[i * 256] += gt[1] * inv * O0[i]; park[(16 + i) * 256] += gt[1] * inv * O1[i]; }
    }
    {
        const u16* Kb = Z + ZC_KW;
        const u16* Vt = (const u16*)(p.ws + OFF_VTW) + (size_t)b * 64 * SEQ;
        zero16(O0); zero16(O1); m = -1e30f; l = 0.f;
        const int j0 = max(0, q0 - 511) >> 6;
        tile_fetch(tr, tid, Kb + (size_t)(j0 * 64) * ZW, ZW, Vt + j0 * 64, SEQ);
        tile_store(tr, tid, stg);
        __syncthreads();
        for (int j = j0; j <= cur; ++j) {
            if (j < cur) tile_fetch(tr, tid, Kb + (size_t)((j + 1) * 64) * ZW, ZW, Vt + (j + 1) * 64, SEQ);
            const int key0 = j * 64;
            const int lhi = t - key0 - 4 * h, llo = lhi - 512;
            if (key0 + 63 <= q0 && key0 > q0 + 31 - 512) flash_tile(lane, stg + ((j - j0) & 1) * STAGE_U16, qf, O0, O1, m, l, [&](int kb, int c, float sv) { return sv; });
            else flash_tile(lane, stg + ((j - j0) & 1) * STAGE_U16, qf, O0, O1, m, l, [&](int kb, int c, float sv) { const int o = 32 * kb + c; return ((o <= lhi) && (o > llo)) ? sv : -INFINITY; });
            if (j < cur) tile_store(tr, tid, stg + ((j - j0 + 1) & 1) * STAGE_U16);
            __syncthreads();
        }
        const float lt = l + __shfl_xor(l, 32);
        const float inv = lt > 0.f ? 1.f / lt : 0.f;
#pragma unroll
        for (int i = 0; i < 16; ++i) { O0[i] = park[i * 256] + gt[2] * inv * O0[i]; O1[i] = park[(16 + i) * 256] + gt[2] * inv * O1[i]; }
    }
    store_o((u16*)(p.ws + OFF_CONCAT) + (size_t)(b * SEQ + t) * 1024 + 768 + hd * 64, O0, O1, h);
}

DI void phase_mix_b(const Params& p, int layer, unsigned char* smem) {
    int* ctr = (int*)(p.ws + OFF_CNT) + 64 + layer * 2 + 1;
    for (;;) {
        const int it = next_item(ctr, smem);
        if (it >= 1024) break;
        const int kind = it & 1, r = it >> 1;
        if (kind == 0) { const int b = r & 3, hd = (r >> 2) & 3, qt = 31 - (r >> 4); item_dsa_attn(p, (b << 7) | (hd << 5) | qt, smem); if (REP2 & 16) item_dsa_attn(p, (b << 7) | (hd << 5) | qt, smem); }
        else { const int b = r & 3, qt = 127 - (r >> 2);
#pragma unroll 1
            for (int rep = 0; rep < 1 + ((REP2 >> 5) & 1); ++rep) item_nsa(p, (b << 7) | qt, smem); }
    }
}

#define XB_TMO      128
#define XB_XCNT(j)  (256  + 64 * (j))
#define XB_XSUB(j)  (1280 + 64 * (j))
#define XB_XGEN(j)  (2304 + 64 * (j))
#define XB_TOP      3328
#define XB_TOPGEN   3392
#define XCD_BAR_WORDS 3456
#define XB_SPIN_CAP (1u << 23)
DI unsigned xb_ld(unsigned* p)              { return __hip_atomic_load(p, __ATOMIC_RELAXED, __HIP_MEMORY_SCOPE_AGENT); }
DI unsigned xb_add(unsigned* p, unsigned v) { return __hip_atomic_fetch_add(p, v, __ATOMIC_RELAXED, __HIP_MEMORY_SCOPE_AGENT); }
DI unsigned xb_xcc_id() { return (unsigned)__builtin_amdgcn_s_getreg((3 << 11) | 20) & 0xFu; }
#define XB_SPIN(cond, bar) do { unsigned _sp = 0; while (cond) { __builtin_amdgcn_s_sleep(1); \
    if ((++_sp & 255u) == 0u) { if (xb_ld(&(bar)[XB_TMO])) break; if (_sp > XB_SPIN_CAP) { atomicAdd(&(bar)[XB_TMO], 1u); break; } } } } while (0)
struct XcdBarrier { unsigned* bar; unsigned x; volatile LAS unsigned* st; };
DI XcdBarrier xcd_barrier_post(unsigned* bar, volatile LAS unsigned* st) {
    XcdBarrier b; b.bar = bar; b.x = xb_xcc_id(); b.st = st;
    if (threadIdx.x == 0) (void)xb_add(&bar[XB_XCNT(b.x)], 1u);
    return b;
}
DI void xcd_barrier_complete(unsigned* bar, unsigned x, unsigned& nloc, unsigned& nx) {
    const unsigned G = gridDim.x * gridDim.y * gridDim.z;
    unsigned sum, cnt, mine, sp = 0u;
    for (;;) {
        sum = 0u; cnt = 0u; mine = 0u;
#pragma unroll
        for (unsigned j = 0; j < 16; ++j) { const unsigned c = xb_ld(&bar[XB_XCNT(j)]); sum += c; cnt += (c > 0u) ? 1u : 0u; mine = (j == x) ? c : mine; }
        if (sum == G) break;
        __builtin_amdgcn_s_sleep(1);
        if ((++sp & 255u) == 0u) { if (xb_ld(&bar[XB_TMO])) break; if (sp > XB_SPIN_CAP) { atomicAdd(&bar[XB_TMO], 1u); break; } }
    }
    nloc = mine > 0u ? mine : 1u; nx = cnt > 0u ? cnt : 1u;
}
DI void xcd_barrier(const XcdBarrier& b) {
    asm volatile("s_waitcnt vmcnt(0)" ::: "memory");
    __syncthreads();
    if (threadIdx.x == 0) {
        unsigned* bar = b.bar;
        __builtin_amdgcn_s_waitcnt(0);
        unsigned nloc = b.st[0], nx = b.st[1];
        if (nloc == 0u) { xcd_barrier_complete(bar, b.x, nloc, nx); b.st[0] = nloc; b.st[1] = nx; }
        const unsigned old = xb_add(&bar[XB_XSUB(b.x)], 1u);
        const unsigned gen = old / nloc;
        if (old + 1u == (gen + 1u) * nloc) {
            __builtin_amdgcn_fence(__ATOMIC_RELEASE, "agent");
            asm volatile("s_waitcnt vmcnt(0)" ::: "memory");
            const unsigned og = xb_add(&bar[XB_TOP], 1u);
            const unsigned tg = og / nx;
            if (og + 1u == (tg + 1u) * nx) xb_add(&bar[XB_TOPGEN], 1u);
            else XB_SPIN(xb_ld(&bar[XB_TOPGEN]) == tg, bar);
            __builtin_amdgcn_fence(__ATOMIC_ACQUIRE, "agent");
            xb_add(&bar[XB_XGEN(b.x)], 1u);
            asm volatile("s_waitcnt vmcnt(0)" ::: "memory");
        } else {
            XB_SPIN(xb_ld(&bar[XB_XGEN(b.x)]) == gen, bar);
            __builtin_amdgcn_fence(__ATOMIC_ACQUIRE, "agent");
            asm volatile("s_waitcnt vmcnt(0)" ::: "memory");
        }
    }
    __syncthreads();
}

constexpr int NPHASE = 18;
__global__ void __launch_bounds__(256, 2) mega(Params p) {
    extern __shared__ __attribute__((aligned(16))) unsigned char smem[];
#if COOP
    if (threadIdx.x == 0) *(uint4*)(smem + SMEM_BYTES - 32) = make_uint4(0u, 0u, 0u, 0u);
    __syncthreads();
    const XcdBarrier xb = xcd_barrier_post((unsigned*)(p.ws + OFF_BAR), (volatile LAS unsigned*)(smem + SMEM_BYTES - 32));
    if (p.ph_hi > 1000000) cg::this_grid().sync();
#endif
#if COOP
#define GSYNC() xcd_barrier(xb)
#else
#define GSYNC()
#endif
#ifndef REPMASK
#define REPMASK 0
#endif
#define RUNPH(k, call) if (p.ph_lo <= (k) && (k) < p.ph_hi) { call; if ((k) + 1 < p.ph_hi) { GSYNC(); } }
#define RUNPHR(k, kind, call) if (p.ph_lo <= (k) && (k) < p.ph_hi) { call; if ((REPMASK >> (kind)) & 1) { GSYNC(); call; } if ((k) + 1 < p.ph_hi) { GSYNC(); } }
    RUNPHR(0, 0, phase0(p, smem))
#pragma unroll 1
    for (int layer = 0; layer < 2; ++layer) {
        const int pb = 1 + 8 * layer;
        RUNPHR(pb + 0, 1, phase_rownorm<0>(p, layer))
        RUNPHR(pb + 1, 2, phase_inproj(p, layer, smem))
        RUNPHR(pb + 2, 3, phase_mix_a(p, layer, smem))
        RUNPHR(pb + 3, 4, phase_mix_b(p, layer, smem))
        RUNPH(pb + 4, phase_outproj(p, layer, smem); if (((REPMASK >> 5) & 1) && layer == 0) { GSYNC(); phase_outproj(p, layer, smem); })
        RUNPH(pb + 5, phase_router<false>(p, layer, smem); if ((REPMASK >> 6) & 1) { GSYNC(); phase_router<true>(p, layer, smem); })
        RUNPHR(pb + 6, 7, phase_moe_gu(p, layer, smem))
        RUNPH(pb + 7, if ((REPMASK >> 8) & 1) { phase_moe_down<true>(p, layer, smem); GSYNC(); } phase_moe_down<false>(p, layer, smem))
    }
    RUNPH(NPHASE - 1, phase_rownorm<2>(p, 0))
#if TKCHECK
    GSYNC();
    if (blockIdx.x == 0 && threadIdx.x == 0) {
        const int bad = __hip_atomic_load((int*)(p.ws + OFF_CNT) + 100, __ATOMIC_RELAXED, __HIP_MEMORY_SCOPE_AGENT);
        const int hits = __hip_atomic_load((int*)(p.ws + OFF_CNT) + 101, __ATOMIC_RELAXED, __HIP_MEMORY_SCOPE_AGENT);
        if (bad) for (int i = 0; i < 65536; ++i) p.out[i] = 1000.f;
        else if (hits < TKCHECK) for (int i = 0; i < 65536; ++i) p.out[i] = 100.f;
    }
#endif
}

extern "C" void kernel_launch(void* const* d_in, const int* in_sizes, int n_in, void* d_out, int out_size, void* d_ws, size_t ws_size, hipStream_t stream) {
    static int grid = 0;
    if (grid == 0) {
        int dev = 0, cus = 0, per_cu = 0;
        hipGetDevice(&dev);
        hipDeviceGetAttribute(&cus, hipDeviceAttributeMultiprocessorCount, dev);
        hipFuncSetAttribute((const void*)mega, hipFuncAttributeMaxDynamicSharedMemorySize, SMEM_BYTES);
        hipOccupancyMaxActiveBlocksPerMultiprocessor(&per_cu, mega, 256, SMEM_BYTES);
        if (per_cu < 1) per_cu = 1;
        if (per_cu > 2) per_cu = 2;
        grid = cus * per_cu;
        if (ws_size < WS_END) { fprintf(stderr, "workspace too small: %zu < %zu\n", ws_size, (size_t)WS_END); grid = -1; }
    }
    if (grid < 0) return;
    Params p{};
    p.x = (const float*)d_in[0]; p.c = (const float*)d_in[1]; p.pos = (const int*)d_in[2];
    p.ada_w = (const float*)d_in[3]; p.ada_b = (const float*)d_in[4]; p.g_mix = (const float*)d_in[5]; p.g_ffn = (const float*)d_in[6];
    p.w_in = (const float*)d_in[7]; p.sgu_g = (const float*)d_in[8]; p.w_sgu = (const float*)d_in[9]; p.b_sgu = (const float*)d_in[10];
    p.w_pool = (const float*)d_in[11]; p.pool_scale = (const float*)d_in[12]; p.w_cmp1 = (const float*)d_in[13]; p.w_cmp2 = (const float*)d_in[14];
    p.cmp_pe = (const float*)d_in[15]; p.w_out = (const float*)d_in[16]; p.router_w = (const float*)d_in[17]; p.router_b = (const float*)d_in[18];
    p.w_gate = (const float*)d_in[19]; p.w_up = (const float*)d_in[20]; p.w_down = (const float*)d_in[21]; p.final_g = (const float*)d_in[22];
    p.out = (float*)d_out; p.ws = (unsigned char*)d_ws;
#if COOP
    hipMemsetAsync((char*)d_ws + OFF_BAR, 0, 16384, stream);
    p.ph_lo = 0; p.ph_hi = NPHASE;
    void* args[] = {&p};
    hipError_t e = hipLaunchCooperativeKernel((void*)mega, dim3(grid), dim3(256), args, SMEM_BYTES, stream);
    if (e != hipSuccess) fprintf(stderr, "cooperative launch failed: %s (grid %d)\n", hipGetErrorString(e), grid);
#else
    for (int ph = 0; ph < NPHASE; ++ph) {
        p.ph_lo = ph; p.ph_hi = ph + 1;
        hipLaunchKernelGGL(mega, dim3(grid), dim3(256), SMEM_BYTES, stream, p);
    }
#endif
}
```

```cpp
#include <hip/hip_runtime.h>
#include <hip/hip_cooperative_groups.h>
#include <cstdio>
#include <cstdint>
namespace cg = cooperative_groups;

#ifndef COOP
#define COOP 1
#ifndef TKCHECK
#define TKCHECK 0
#endif
#ifndef TKD
#define TKD 0
#endif
#ifndef SWAPMODE
#define SWAPMODE 1
#endif
#endif

typedef unsigned short u16;
typedef unsigned int u32;
typedef unsigned long long u64;
typedef short bf16x8 __attribute__((ext_vector_type(8)));
typedef float f32x4 __attribute__((ext_vector_type(4)));
typedef float f32x16 __attribute__((ext_vector_type(16)));
typedef u32 u32x4 __attribute__((ext_vector_type(4)));
typedef u32 u32x2 __attribute__((ext_vector_type(2)));
#define DI __device__ __forceinline__
#define LAS __attribute__((address_space(3)))
constexpr int SMEM_BYTES = 76288;

constexpr int NB = 4, SEQ = 4096, DM = 1024, NTOK = NB * SEQ;
constexpr int ZW = 2432;
constexpr int ZC_AQ = 0, ZC_AK = 256, ZC_AV = 512, ZC_IQ = 768, ZC_IK = 896, ZC_IW = 928, ZC_DG = 932, ZC_BU = 960, ZC_BV = 1216,
              ZC_CZ = 1472, ZC_DQ = 1728, ZC_KC = 1984, ZC_VC = 2048, ZC_KS = 2112, ZC_VS = 2176, ZC_KW = 2240, ZC_VW = 2304, ZC_END = 2368;
constexpr int IN_WIDTH = 2352;
constexpr int NCLS = 24;

constexpr size_t al256(size_t x) { return (x + 255) & ~(size_t)255; }
constexpr size_t OFF_WIN = 0;
constexpr size_t OFF_WOUT = OFF_WIN + 2ull * ZW * 1024 * 2;
constexpr size_t OFF_WGU = OFF_WOUT + 2ull * 1024 * 1024 * 2;
constexpr size_t OFF_WD = OFF_WGU + 2ull * 16 * 512 * 1024 * 2;
constexpr size_t OFF_WSGU = OFF_WD + 2ull * 16 * 1024 * 256 * 2;
constexpr size_t OFF_MOD = OFF_WSGU + 2ull * 4 * 128 * 128 * 2;
constexpr size_t OFF_ROPE = OFF_MOD + 2ull * 4 * 6144 * 4;
constexpr size_t OFF_H = OFF_ROPE + (size_t)NTOK * 8 * 8;
constexpr size_t OFF_Z = OFF_H + (size_t)NTOK * 1024 * 2;
constexpr size_t OFF_VTA = OFF_Z + (size_t)NTOK * ZW * 2;
constexpr size_t OFF_VTS = OFF_VTA + 4ull * 4 * 64 * 4096 * 2;
constexpr size_t OFF_VTW = OFF_VTS + 4ull * 64 * 4096 * 2;
constexpr size_t OFF_KCMP = OFF_VTW + 4ull * 64 * 4096 * 2;
constexpr size_t OFF_VCMPT = OFF_KCMP + 4ull * 256 * 64 * 2;
constexpr size_t OFF_MASK = OFF_VCMPT + 4ull * 64 * 256 * 2;
constexpr size_t OFF_CONCAT = OFF_MASK + 4ull * 64 * 4096 * 8;
constexpr size_t OFF_LIST = OFF_CONCAT + (size_t)NTOK * 1024 * 2;
constexpr size_t OFF_TOKW = OFF_LIST + 2ull * NCLS * NTOK * 4;
constexpr size_t OFF_CNT = OFF_TOKW + (size_t)NTOK * 2 * 4;
constexpr size_t OFF_IKC = OFF_CNT + 1024;
constexpr size_t OFF_PARK = OFF_IKC + (size_t)NTOK * 32 * 2;
constexpr size_t OFF_BAR = OFF_PARK + 512ull * 32 * 256 * 4;
constexpr size_t OFF_W1T = OFF_BAR + 16384;
constexpr size_t OFF_CBIAS = OFF_W1T + 2ull * 2 * 64 * 2048 * 2;
constexpr size_t OFF_RWT = OFF_CBIAS + 4ull * 64 * 64 * 4;
constexpr size_t WS_END = OFF_RWT + 16ull * 1024 * 4;
constexpr size_t OFF_HID = OFF_Z;

struct Params {
    const float *x, *c; const int* pos;
    const float *ada_w, *ada_b, *g_mix, *g_ffn, *w_in, *sgu_g, *w_sgu, *b_sgu, *w_pool, *pool_scale, *w_cmp1, *w_cmp2, *cmp_pe,
                *w_out, *router_w, *router_b, *w_gate, *w_up, *w_down, *final_g;
    float* out; unsigned char* ws;
    int ph_lo, ph_hi;
};

typedef __bf16 hbf16x2 __attribute__((ext_vector_type(2)));
typedef float f32x2v __attribute__((ext_vector_type(2)));
DI u16 f2bf(float f) { return __builtin_bit_cast(u16, (__bf16)f); }
DI float bf2f(u16 h) { return __uint_as_float(((u32)h) << 16); }
DI u32 pack2(float a, float b) { const f32x2v v = {a, b}; return __builtin_bit_cast(u32, __builtin_convertvector(v, hbf16x2)); }
template <int OFF> DI int sxi(int v) { static_assert(OFF >= 1 && OFF < 32, "swizzle"); return __builtin_amdgcn_ds_swizzle(v, (OFF << 10) | 0x1f); }
template <int OFF> DI u32 sxu(u32 v) { return (u32)sxi<OFF>((int)v); }
template <int OFF> DI float sxf(float v) { return __int_as_float(sxi<OFF>(__float_as_int(v))); }
template <int OFF> DI u64 sxq(u64 v) { return (u64)sxu<OFF>((u32)v) | ((u64)sxu<OFF>((u32)(v >> 32)) << 32); }
DI u16* res_row(float* out, size_t row) { return (u16*)out + row * 2048 + 1024; }
DI float4 ld_res4(const u16* q) { const uint2 v = *(const uint2*)q; float4 r; r.x = __uint_as_float(v.x << 16); r.y = __uint_as_float(v.x & 0xffff0000u); r.z = __uint_as_float(v.y << 16); r.w = __uint_as_float(v.y & 0xffff0000u); return r; }
DI void st_res4(u16* q, float a, float b, float c, float d) { uint2 pk; pk.x = pack2(a, b); pk.y = pack2(c, d); *(uint2*)q = pk; }
DI float wave_sum(float v) {
    v += __shfl_xor(v, 32); v += sxf<16>(v); v += sxf<8>(v); v += sxf<4>(v); v += sxf<2>(v); v += sxf<1>(v);
    return v;
}
DI int otid() { int t = threadIdx.x; asm volatile("" : "+v"(t)); return t; }
DI int block_or(int pred, unsigned char* smem) {
    volatile int* f = (volatile int*)(smem + SMEM_BYTES - 48);
    __syncthreads();
    if (threadIdx.x == 0) *f = 0;
    __syncthreads();
    if (pred) *f = 1;
    __syncthreads();
    return *f;
}
DI void wave_lds_fence() { asm volatile("s_waitcnt lgkmcnt(0)" ::: "memory"); }
DI float gelu_tanh(float x) { const float u = 0.7978845608028654f * (x + 0.044715f * x * x * x);
    return x * __builtin_amdgcn_rcpf(1.f + __builtin_amdgcn_exp2f(-2.885390081777927f * u)); }
DI float sigmoidf_(float x) { return 1.f / (1.f + __expf(-x)); }
DI int perm16(int k) { return ((k & 4) << 1) | ((k & 8) >> 1) | (k & 3); }
#define MFMA16(a, b, c) __builtin_amdgcn_mfma_f32_16x16x32_bf16((a), (b), (c), 0, 0, 0)
#define MFMA32(a, b, c) __builtin_amdgcn_mfma_f32_32x32x16_bf16((a), (b), (c), 0, 0, 0)

DI int win_colmap(int n) { return n < 932 ? n : (n < 944 ? 2340 + (n - 932) : (n < 960 ? -1 : (n < ZC_END ? n - 28 : -1))); }

constexpr int P0_T_WIN = 2 * (ZW / 64) * 16;
constexpr int P0_T_WOUT = 2 * 16 * 16;
constexpr int P0_T_WGU = 2 * 16 * 8 * 16;
constexpr int P0_T_WD = 2 * 16 * 16 * 4;
constexpr int P0_TILES = P0_T_WIN + P0_T_WOUT + P0_T_WGU + P0_T_WD;
constexpr int P0_MOD = 2 * 96;
constexpr int P0_ROPE = NTOK * 8 / 256;
constexpr int P0_SGU = 2 * 4 * 128 * 128 / 2048;
constexpr int P0_W1 = 2 * 2 * 32;
constexpr int P0_CB = 64;
constexpr int P0_ITEMS = P0_TILES + P0_MOD + P0_ROPE + P0_SGU + P0_W1 + P0_CB + 1;

struct WtD { const float* src; u16* dst; int ldsrc, Kdim, n0, k0, kind, l, e; };
DI WtD wt_decode(const Params& p, int t) {
    WtD d; d.e = 0;
    if (t < P0_T_WIN) { d.kind = 0; d.l = t / 608; int r = t % 608; d.n0 = (r / 16) * 64; d.k0 = (r % 16) * 64; d.src = p.w_in + (size_t)d.l * 1024 * IN_WIDTH; d.ldsrc = IN_WIDTH; d.Kdim = 1024;
        d.dst = (u16*)(p.ws + OFF_WIN) + (size_t)d.l * ZW * 1024; }
    else if ((t -= P0_T_WIN) < P0_T_WOUT) { d.kind = 1; d.l = t / 256; int r = t % 256; d.n0 = (r / 16) * 64; d.k0 = (r % 16) * 64; d.src = p.w_out + (size_t)d.l * 1024 * 1024; d.ldsrc = 1024; d.Kdim = 1024;
        d.dst = (u16*)(p.ws + OFF_WOUT) + (size_t)d.l * 1024 * 1024; }
    else if ((t -= P0_T_WOUT) < P0_T_WGU) { d.kind = 2; d.l = t / 2048; int r = t % 2048; d.e = r / 128; r %= 128; d.n0 = (r / 16) * 64; d.k0 = (r % 16) * 64; d.src = nullptr; d.ldsrc = 256; d.Kdim = 1024;
        d.dst = (u16*)(p.ws + OFF_WGU) + (size_t)(d.l * 16 + d.e) * 512 * 1024; }
    else { t -= P0_T_WGU; d.kind = 3; d.l = t / 1024; int r = t % 1024; d.e = r / 64; r %= 64; d.n0 = (r / 4) * 64; d.k0 = (r % 4) * 64; d.src = p.w_down + (size_t)(d.l * 16 + d.e) * 256 * 1024; d.ldsrc = 1024; d.Kdim = 256;
        d.dst = (u16*)(p.ws + OFF_WD) + (size_t)(d.l * 16 + d.e) * 1024 * 256; }
    return d;
}
DI void wt_load(const Params& p, const WtD& d, const int tid, f32x4 (&v)[4]) {
    if (d.kind == 1 || d.kind == 3) {
#pragma unroll
        for (int i = 0; i < 4; ++i) v[i] = *(const f32x4*)(d.src + (size_t)(d.k0 + i * 16 + (tid >> 4)) * d.ldsrc + d.n0 + (tid & 15) * 4);
    } else {
        const int n = d.n0 + (tid & 63);
        if (d.kind == 0) {
            const int c = win_colmap(n);
#pragma unroll
            for (int i = 0; i < 4; ++i)
#pragma unroll
                for (int j = 0; j < 4; ++j) v[i][j] = (c >= 0) ? d.src[(size_t)(d.k0 + (4 * i + j) * 4 + (tid >> 6)) * d.ldsrc + c] : 0.f;
        } else {
            const int t16 = n >> 4, col = (t16 >> 1) * 16 + (n & 15);
            const float* s2 = ((t16 & 1) ? p.w_up : p.w_gate) + (size_t)(d.l * 16 + d.e) * 1024 * 256;
#pragma unroll
            for (int i = 0; i < 4; ++i)
#pragma unroll
                for (int j = 0; j < 4; ++j) v[i][j] = s2[(size_t)(d.k0 + (4 * i + j) * 4 + (tid >> 6)) * 256 + col];
        }
    }
}
DI void wt_to_lds(const WtD& d, const int tid, const f32x4 (&v)[4], float* tile) {
    if (d.kind == 1 || d.kind == 3) {
#pragma unroll
        for (int i = 0; i < 4; ++i) *(f32x4*)(tile + (i * 16 + (tid >> 4)) * 68 + (tid & 15) * 4) = v[i];
    } else {
#pragma unroll
        for (int i = 0; i < 4; ++i)
#pragma unroll
            for (int j = 0; j < 4; ++j) tile[((4 * i + j) * 4 + (tid >> 6)) * 68 + (tid & 63)] = v[i][j];
    }
}
DI void wt_store(const WtD& d, const int tid, const float* tile) {
#pragma unroll
    for (int i = 0; i < 2; ++i) {
        const int n = i * 32 + (tid >> 3), k8 = (tid & 7) * 8;
        u32x4 o;
#pragma unroll
        for (int j = 0; j < 4; ++j) o[j] = pack2(tile[(k8 + 2 * j) * 68 + n], tile[(k8 + 2 * j + 1) * 68 + n]);
        *(u32x4*)(d.dst + (size_t)(d.n0 + n) * d.Kdim + d.k0 + k8) = o;
    }
}
DI void wtile(const Params& p, int t, unsigned char* smem, const int tid) {
    const WtD d = wt_decode(p, t);
    f32x4 v[4];
    wt_load(p, d, tid, v);
    __syncthreads();
    wt_to_lds(d, tid, v, (float*)smem);
    __syncthreads();
    wt_store(d, tid, (const float*)smem);
}
DI void wtile4(const Params& p, int t0, int t1, int t2, int t3, unsigned char* smem, const int tid) {
    const WtD d0 = wt_decode(p, t0), d1 = wt_decode(p, t1), d2 = wt_decode(p, t2), d3 = wt_decode(p, t3);
    f32x4 v0[4], v1[4], v2[4], v3[4];
    wt_load(p, d0, tid, v0); wt_load(p, d1, tid, v1); wt_load(p, d2, tid, v2); wt_load(p, d3, tid, v3);
    float* tl = (float*)smem;
    __syncthreads();
    wt_to_lds(d0, tid, v0, tl); wt_to_lds(d1, tid, v1, tl + 4352); wt_to_lds(d2, tid, v2, tl + 8704); wt_to_lds(d3, tid, v3, tl + 13056);
    __syncthreads();
    wt_store(d0, tid, tl); wt_store(d1, tid, tl + 4352); wt_store(d2, tid, tl + 8704); wt_store(d3, tid, tl + 13056);
}
constexpr int P0_NOW = 608;
constexpr int WT_DEFER = (P0_TILES - P0_NOW) / 8;
constexpr int WT_A = (256 + 2048 + 1024) / 8, WT_B = (608 + 256 + 2048 + 1024) / 8;
DI int wt_tile_a(int a) { return a < 256 ? 1216 + a : (a < 2304 ? 1728 + (a - 256) : 5824 + (a - 2304)); }
DI int wt_tile_b(int b) { return b < 608 ? 608 + b : (b < 864 ? 1472 + (b - 608) : (b < 2912 ? 3776 + (b - 864) : 6848 + (b - 2912))); }
constexpr int P0_MOD_NOW = 32;
DI void mod_item(const Params& p, int t, unsigned char* smem, const int tid) {
    const int l = t / 96, n0 = (t % 96) * 64;
    float* sc = (float*)smem;
    float* red = sc + 4096;
    __syncthreads();
    for (int i = tid; i < 4096; i += 256) { const float cv = p.c[i]; sc[i] = cv / (1.f + __expf(-cv)); }
    __syncthreads();
    const int col = n0 + (tid & 63), kq = tid >> 6;
    float a0 = 0.f, a1 = 0.f, a2 = 0.f, a3 = 0.f;
    const float* w = p.ada_w + (size_t)l * 1024 * 6144 + col;
#pragma unroll 1
    for (int k0 = kq * 256; k0 < kq * 256 + 256; k0 += 32) {
        float wv[32];
#pragma unroll
        for (int j = 0; j < 32; ++j) wv[j] = w[(size_t)(k0 + j) * 6144];
#pragma unroll
        for (int j = 0; j < 32; ++j) { a0 += sc[k0 + j] * wv[j]; a1 += sc[1024 + k0 + j] * wv[j]; a2 += sc[2048 + k0 + j] * wv[j]; a3 += sc[3072 + k0 + j] * wv[j]; }
    }
    red[(kq * 4 + 0) * 64 + (tid & 63)] = a0; red[(kq * 4 + 1) * 64 + (tid & 63)] = a1; red[(kq * 4 + 2) * 64 + (tid & 63)] = a2; red[(kq * 4 + 3) * 64 + (tid & 63)] = a3;
    __syncthreads();
    { const int b = tid >> 6, cc = tid & 63; float s = red[(0 * 4 + b) * 64 + cc] + red[(1 * 4 + b) * 64 + cc] + red[(2 * 4 + b) * 64 + cc] + red[(3 * 4 + b) * 64 + cc];
      ((float*)(p.ws + OFF_MOD))[(size_t)(l * 4 + b) * 6144 + n0 + cc] = s + p.ada_b[(size_t)l * 6144 + n0 + cc]; }
}
DI void phase0(const Params& p, unsigned char* smem) {
    const int tid = otid();
    for (int it = blockIdx.x; it < P0_ITEMS; it += gridDim.x) {
        if (it < P0_TILES) {
            if (it < P0_NOW / 4) wtile4(p, 4 * it, 4 * it + 1, 4 * it + 2, 4 * it + 3, smem, tid);
        } else if (it < P0_TILES + P0_MOD) {
            const int t = it - P0_TILES;
            if (t < P0_MOD_NOW) mod_item(p, t, smem, tid);
        } else if (it < P0_TILES + P0_MOD + P0_ROPE) {
            const int idx = (it - P0_TILES - P0_MOD) * 256 + tid, tok = idx >> 3, i = idx & 7;
            const double inv = exp(-((double)i / 8.0) * log(500000.0));
            const double ang = (double)p.pos[tok] * inv;
            float2 cs; cs.x = (float)cos(ang); cs.y = (float)sin(ang);
            ((float2*)(p.ws + OFF_ROPE))[idx] = cs;
        } else if (it < P0_TILES + P0_MOD + P0_ROPE + P0_SGU) {
            const int base = (it - P0_TILES - P0_MOD - P0_ROPE) * 2048;
            for (int i = tid; i < 2048; i += 256) { const int idx = base + i, s = idx & 127, t = (idx >> 7) & 127; ((u16*)(p.ws + OFF_WSGU))[idx] = (s <= t) ? f2bf(p.w_sgu[idx]) : (u16)0; }
        } else if (it < P0_TILES + P0_MOD + P0_ROPE + P0_SGU + P0_W1) {
            const int t = it - (P0_TILES + P0_MOD + P0_ROPE + P0_SGU), lk = t >> 5, k0 = (t & 31) * 64;
            const float* src = p.w_cmp1 + (size_t)lk * 2048 * 64;
            u16* dst = (u16*)(p.ws + OFF_W1T) + (size_t)lk * 64 * 2048;
            float* tile = (float*)smem;
            __syncthreads();
#pragma unroll
            for (int i = 0; i < 4; ++i) {
                const int k = i * 16 + (tid >> 4), c4 = (tid & 15) * 4;
                *(f32x4*)(tile + k * 68 + c4) = *(const f32x4*)(src + (size_t)(k0 + k) * 64 + c4);
            }
            __syncthreads();
#pragma unroll
            for (int i = 0; i < 2; ++i) {
                const int n = i * 32 + (tid >> 3), k8 = (tid & 7) * 8;
                u32x4 o;
#pragma unroll
                for (int j = 0; j < 4; ++j) o[j] = pack2(tile[(k8 + 2 * j) * 68 + n], tile[(k8 + 2 * j + 1) * 68 + n]);
                *(u32x4*)(dst + (size_t)n * 2048 + k0 + k8) = o;
            }
        } else if (it < P0_TILES + P0_MOD + P0_ROPE + P0_SGU + P0_W1 + P0_CB) {
            const int t = it - (P0_TILES + P0_MOD + P0_ROPE + P0_SGU + P0_W1), lk = t >> 4, ch = t & 15;
            const int e = tid & 63, q = tid >> 6, j0 = ch * 128 + q * 32;
            const float* w1 = p.w_cmp1 + (size_t)lk * 2048 * 64 + e; const float* pe = p.cmp_pe + (size_t)lk * 2048;
            float wv[32];
#pragma unroll
            for (int j = 0; j < 32; ++j) wv[j] = w1[(size_t)(j0 + j) * 64];
            float a = 0.f;
#pragma unroll
            for (int j = 0; j < 32; ++j) a += pe[j0 + j] * wv[j];
            ((float*)(p.ws + OFF_CBIAS))[(size_t)(lk * 64 + ch * 4 + q) * 64 + e] = a;
        } else {
            if (tid < 128) ((int*)(p.ws + OFF_CNT))[tid] = 0;
            float* rwt = (float*)(p.ws + OFF_RWT);
            for (int i = tid; i < 4096; i += 256) {
                const f32x4 v = ((const f32x4*)p.router_w)[i];
                const int k = i >> 2, e0 = (i & 3) * 4;
                rwt[(e0 + 0) * 1024 + k] = v[0]; rwt[(e0 + 1) * 1024 + k] = v[1]; rwt[(e0 + 2) * 1024 + k] = v[2]; rwt[(e0 + 3) * 1024 + k] = v[3];
            }
        }
    }
}

template <int MODE> DI void phase_rownorm(const Params& p, int layer) {
    const int tid0 = otid(); const int lane = tid0 & 63, wave = tid0 >> 6;
    const bool fromx = (MODE == 0 && layer == 0);
    const float* mod = (const float*)(p.ws + OFF_MOD);
    float gs[16], shv[16];
#define RN_PARAMS(B) { \
        if (MODE == 2) { _Pragma("unroll") for (int i = 0; i < 4; ++i) { const float4 g = *(const float4*)(p.final_g + 4 * lane + 256 * i); gs[4 * i] = g.x; gs[4 * i + 1] = g.y; gs[4 * i + 2] = g.z; gs[4 * i + 3] = g.w; } } \
        else { const float* gg = p.g_mix + (size_t)layer * 1024; const float* msh = mod + (size_t)(layer * 4 + (B)) * 6144; const float* msc = msh + 1024; \
            _Pragma("unroll") for (int i = 0; i < 4; ++i) { const int c0 = 4 * lane + 256 * i; \
                const float4 g = *(const float4*)(gg + c0), sh = *(const float4*)(msh + c0), sc = *(const float4*)(msc + c0); \
                gs[4 * i] = g.x * (1.f + sc.x); gs[4 * i + 1] = g.y * (1.f + sc.y); gs[4 * i + 2] = g.z * (1.f + sc.z); gs[4 * i + 3] = g.w * (1.f + sc.w); \
                shv[4 * i] = sh.x; shv[4 * i + 1] = sh.y; shv[4 * i + 2] = sh.z; shv[4 * i + 3] = sh.w; } } }
#define RN_ROW(ROW) { \
        const int row = (ROW); \
        float4 v[4]; \
        _Pragma("unroll") for (int i = 0; i < 4; ++i) v[i] = fromx ? *(const float4*)(p.x + (size_t)row * 1024 + 4 * lane + 256 * i) : ld_res4(res_row(p.out, row) + 4 * lane + 256 * i); \
        float ss = 0.f; \
        _Pragma("unroll") for (int i = 0; i < 4; ++i) ss += v[i].x * v[i].x + v[i].y * v[i].y + v[i].z * v[i].z + v[i].w * v[i].w; \
        ss = wave_sum(ss); \
        const float rstd = rsqrtf(ss * (1.f / 1024.f) + 1e-6f); \
        if (MODE == 2) { \
            _Pragma("unroll") for (int i = 0; i < 4; ++i) { float4 o; o.x = v[i].x * rstd * gs[4 * i]; o.y = v[i].y * rstd * gs[4 * i + 1]; o.z = v[i].z * rstd * gs[4 * i + 2]; o.w = v[i].w * rstd * gs[4 * i + 3]; \
                *(float4*)(p.out + (size_t)row * 1024 + 4 * lane + 256 * i) = o; } \
        } else { \
            u16* hrow = (u16*)(p.ws + OFF_H) + (size_t)row * 1024; \
            _Pragma("unroll") for (int i = 0; i < 4; ++i) { \
                uint2 pk; pk.x = pack2(v[i].x * rstd * gs[4 * i] + shv[4 * i], v[i].y * rstd * gs[4 * i + 1] + shv[4 * i + 1]); \
                pk.y = pack2(v[i].z * rstd * gs[4 * i + 2] + shv[4 * i + 2], v[i].w * rstd * gs[4 * i + 3] + shv[4 * i + 3]); \
                *(uint2*)(hrow + 4 * lane + 256 * i) = pk; } } }
    const int G = (int)gridDim.x;
    if ((G & 3) == 0) {
        const int bb = (int)blockIdx.x & 3, ib = (int)blockIdx.x >> 2, rstride = (G >> 2) * 4;
        RN_PARAMS(bb)
        for (int r = ib * 4 + wave; r < SEQ; r += rstride) RN_ROW(bb * SEQ + r)
    } else {
        for (int row_ = blockIdx.x * 4 + wave; row_ < NTOK; row_ += G * 4) { RN_PARAMS(row_ >> 12) RN_ROW(row_) }
    }
#undef RN_PARAMS
#undef RN_ROW
}
template <bool DRY> DI void phase_router(const Params& p, int layer, unsigned char* smem) {
    const int tid0 = otid(); const int lane = tid0 & 63, wave = tid0 >> 6;
    const float* mod = (const float*)(p.ws + OFF_MOD);
    const float* gg = p.g_ffn + (size_t)layer * 1024;
    float* rwT = (float*)smem;
    __syncthreads();
    {
        const f32x4* src = (const f32x4*)(p.ws + OFF_RWT);
        f32x4 v[16];
#pragma unroll
        for (int i = 0; i < 16; ++i) v[i] = src[tid0 + 256 * i];
#pragma unroll
        for (int i = 0; i < 16; ++i) ((f32x4*)rwT)[tid0 + 256 * i] = v[i];
    }
    __syncthreads();
    int* cls_s = (int*)(smem + 65536);
    const float rb_lane = p.router_b[lane >> 2];
    int nround = 0;
    const bool xaff = (gridDim.x % 8 == 0) && (512 % ((gridDim.x >> 3) * 4) == 0);
    const int xg = blockIdx.x & 7, xlb = blockIdx.x >> 3, xnb4 = (gridDim.x >> 3) * 4;
    const int rb0 = xaff ? xg * 512 + xlb * 4 : (int)blockIdx.x * 4, rbs = xaff ? xnb4 : (int)gridDim.x * 4, rbend = xaff ? xg * 512 + 512 : NTOK / 4;
    for (int rbase = rb0; rbase < rbend; rbase += rbs) {
        const int rg = rbase + wave;
        const int row0 = rg * 4, b = row0 >> 12;
        const float* msh = mod + (size_t)(layer * 4 + b) * 6144 + 3 * 1024;
        const float* msc = msh + 1024;
        float rstd[4];
#pragma unroll
        for (int r = 0; r < 4; ++r) {
            float ss = 0.f;
#pragma unroll
            for (int i = 0; i < 4; ++i) { const float4 xv = ld_res4(res_row(p.out, row0 + r) + 4 * lane + 256 * i); ss += xv.x * xv.x + xv.y * xv.y + xv.z * xv.z + xv.w * xv.w; }
            ss = wave_sum(ss);
            rstd[r] = rsqrtf(ss * (1.f / 1024.f) + 1e-6f);
        }
        float part[4][16];
#pragma unroll
        for (int r = 0; r < 4; ++r)
#pragma unroll
            for (int e = 0; e < 16; ++e) part[r][e] = 0.f;
#pragma unroll 2
        for (int i = 0; i < 4; ++i) {
            const int c0 = 4 * lane + 256 * i;
            const float4 g = *(const float4*)(gg + c0), sh = *(const float4*)(msh + c0), sc = *(const float4*)(msc + c0);
            const float gs[4] = {g.x * (1.f + sc.x), g.y * (1.f + sc.y), g.z * (1.f + sc.z), g.w * (1.f + sc.w)};
            const float shv[4] = {sh.x, sh.y, sh.z, sh.w};
            float hv[4][4];
#pragma unroll
            for (int r = 0; r < 4; ++r) {
                const float4 xv = ld_res4(res_row(p.out, row0 + r) + c0);
                const float xr[4] = {xv.x, xv.y, xv.z, xv.w};
#pragma unroll
                for (int j = 0; j < 4; ++j) hv[r][j] = xr[j] * rstd[r] * gs[j] + shv[j];
                uint2 pk; pk.x = pack2(hv[r][0], hv[r][1]); pk.y = pack2(hv[r][2], hv[r][3]);
                *(uint2*)((u16*)(p.ws + OFF_H) + (size_t)(row0 + r) * 1024 + c0) = pk;
            }
#pragma unroll
            for (int e = 0; e < 16; ++e) {
                if ((e & 3) == 0) asm volatile("" ::: "memory");
                const f32x4 w4 = *(const f32x4*)(rwT + e * 1024 + c0);
#pragma unroll
                for (int r = 0; r < 4; ++r) part[r][e] += hv[r][0] * w4[0] + hv[r][1] * w4[1] + hv[r][2] * w4[2] + hv[r][3] * w4[3];
            }
        }
#pragma unroll
        for (int r = 0; r < 4; ++r) {
            float v8[8], v4[4], v2[2];
            const bool h5 = (lane & 32) != 0, h4 = (lane & 16) != 0, h3 = (lane & 8) != 0, h2 = (lane & 4) != 0;
#pragma unroll
            for (int e = 0; e < 8; ++e) { const float mine = h5 ? part[r][e + 8] : part[r][e], send = h5 ? part[r][e] : part[r][e + 8]; v8[e] = mine + __shfl_xor(send, 32); }
#pragma unroll
            for (int e = 0; e < 4; ++e) { const float mine = h4 ? v8[e + 4] : v8[e], send = h4 ? v8[e] : v8[e + 4]; v4[e] = mine + sxf<16>(send); }
#pragma unroll
            for (int e = 0; e < 2; ++e) { const float mine = h3 ? v4[e + 2] : v4[e], send = h3 ? v4[e] : v4[e + 2]; v2[e] = mine + sxf<8>(send); }
            float v1 = (h2 ? v2[1] : v2[0]) + sxf<4>(h2 ? v2[0] : v2[1]);
            v1 += sxf<2>(v1); v1 += sxf<1>(v1);
            float aff[16], bia[16];
            const float afl = 1.f / (1.f + expf(-v1)), bil = afl + rb_lane;
#pragma unroll
            for (int e = 0; e < 16; ++e) { aff[e] = __int_as_float(__builtin_amdgcn_readlane(__float_as_int(afl), 4 * e)); bia[e] = __int_as_float(__builtin_amdgcn_readlane(__float_as_int(bil), 4 * e)); }
            int bg = 0; float bs = -INFINITY;
#pragma unroll
            for (int g = 0; g < 4; ++g) {
                const float a0 = bia[4 * g], a1 = bia[4 * g + 1], a2 = bia[4 * g + 2], a3 = bia[4 * g + 3];
                const float hi01 = fmaxf(a0, a1), lo01 = fminf(a0, a1), hi23 = fmaxf(a2, a3), lo23 = fminf(a2, a3);
                const float t1 = fmaxf(hi01, hi23), t2 = fmaxf(fminf(hi01, hi23), fmaxf(lo01, lo23));
                const float gsum = t1 + t2;
                if (gsum > bs) { bs = gsum; bg = g; }
            }
            float cb[4], ca[4];
#pragma unroll
            for (int i = 0; i < 4; ++i) { cb[i] = bia[i]; ca[i] = aff[i]; }
#pragma unroll
            for (int g = 1; g < 4; ++g)
#pragma unroll
                for (int i = 0; i < 4; ++i) if (bg == g) { cb[i] = bia[4 * g + i]; ca[i] = aff[4 * g + i]; }
            int i1 = 0; float m1 = cb[0];
#pragma unroll
            for (int i = 1; i < 4; ++i) if (cb[i] > m1) { m1 = cb[i]; i1 = i; }
            int i2 = -1; float m2 = -INFINITY;
#pragma unroll
            for (int i = 0; i < 4; ++i) if (i != i1 && cb[i] > m2) { m2 = cb[i]; i2 = i; }
            float af1 = ca[0], af2 = ca[0];
#pragma unroll
            for (int i = 1; i < 4; ++i) { if (i1 == i) af1 = ca[i]; if (i2 == i) af2 = ca[i]; }
            const float inv = 1.f / (af1 + af2);
            const int lo = min(i1, i2), hi = max(i1, i2);
            const float wlo = (lo == i1 ? af1 : af2) * inv, whi = (hi == i1 ? af1 : af2) * inv;
            const int cls = bg * 6 + lo * (7 - lo) / 2 + (hi - lo - 1);
            if (lane == 0) {
                float2 tw; tw.x = wlo; tw.y = whi;
                ((float2*)(p.ws + OFF_TOKW))[row0 + r] = tw;
                cls_s[nround * 16 + wave * 4 + r] = cls;
            }
        }
        ++nround;
    }
    if (!DRY) {
        __syncthreads();
        if (tid0 < NCLS) {
            const int ntok = nround * 16;
            int n = 0;
            for (int i = 0; i < ntok; ++i) n += (cls_s[i] == tid0) ? 1 : 0;
            if (n) {
                int* cnt = (int*)(p.ws + OFF_CNT) + layer * 32;
                int pos = atomicAdd(&cnt[tid0], n);
                int* lst = (int*)(p.ws + OFF_LIST) + (size_t)(layer * NCLS + tid0) * NTOK;
                for (int i = 0; i < ntok; ++i) if (cls_s[i] == tid0) lst[pos++] = (rb0 + (i >> 4) * rbs + ((i >> 2) & 3)) * 4 + (i & 3);
            }
        }
        __syncthreads();
    }
}

#define GAS __attribute__((address_space(1)))
constexpr int GSTAGE = 32768;
constexpr int GEMM_LDS = 2 * GSTAGE;
DI void gemm_core(const int tid, const u16* __restrict__ A, const size_t (&aoff)[4], const u16* __restrict__ Bt, const size_t (&boff)[4], int K, unsigned char* smem, f32x4 (&acc)[4][4],
                  const u16* __restrict__ A2 = nullptr, const u16* __restrict__ Bt2 = nullptr, int ksplit = 1 << 30) {
    const int lane = tid & 63, wave = __builtin_amdgcn_readfirstlane(tid >> 6), wr = wave >> 1, wc = wave & 1, l16 = lane & 15, fq = lane >> 4;
    const int csrc = ((lane & 7) ^ ((lane >> 3) & 7)) * 8;
    auto issue = [&](int k0, int stg) {
        unsigned char* base = smem + stg * GSTAGE + wave * 4096;
        const bool second = k0 >= ksplit;
        const u16* Ap = (second ? A2 - ksplit : A) + k0 + csrc;
        const u16* Bp = (second ? Bt2 - ksplit : Bt) + k0 + csrc;
#pragma unroll
        for (int i = 0; i < 4; ++i) {
            __builtin_amdgcn_global_load_lds((const GAS void*)(Ap + aoff[i]), (LAS void*)(base + i * 1024), 16, 0, 0);
            __builtin_amdgcn_global_load_lds((const GAS void*)(Bp + boff[i]), (LAS void*)(base + 16384 + i * 1024), 16, 0, 0);
        }
    };
    __syncthreads();
    issue(0, 0);
    const int nk = K >> 6;
    const int sw = l16 & 7;
    for (int kt = 0; kt < nk; ++kt) {
        __syncthreads();
        if (kt + 1 < nk) issue((kt + 1) << 6, (kt + 1) & 1);
        const unsigned char* sA = smem + (kt & 1) * GSTAGE;
        const unsigned char* sB = sA + 16384;
        bf16x8 af[2][4], bfr[2][4];
        {
            const int coff = (fq ^ sw) * 16;
#pragma unroll
            for (int mi = 0; mi < 4; ++mi) af[0][mi] = *(const bf16x8*)(sA + (wr * 64 + mi * 16 + l16) * 128 + coff);
#pragma unroll
            for (int ni = 0; ni < 4; ++ni) bfr[0][ni] = *(const bf16x8*)(sB + (wc * 64 + ni * 16 + l16) * 128 + coff);
        }
        __builtin_amdgcn_sched_barrier(0);
#pragma unroll
        for (int ni = 0; ni < 4; ++ni) acc[0][ni] = MFMA16(bfr[0][ni], af[0][0], acc[0][ni]);
        __builtin_amdgcn_sched_barrier(0);
        {
            const int coff = ((4 + fq) ^ sw) * 16;
#pragma unroll
            for (int mi = 0; mi < 4; ++mi) af[1][mi] = *(const bf16x8*)(sA + (wr * 64 + mi * 16 + l16) * 128 + coff);
#pragma unroll
            for (int ni = 0; ni < 4; ++ni) bfr[1][ni] = *(const bf16x8*)(sB + (wc * 64 + ni * 16 + l16) * 128 + coff);
        }
        __builtin_amdgcn_sched_barrier(0);
#pragma unroll
        for (int mi = 1; mi < 4; ++mi)
#pragma unroll
            for (int ni = 0; ni < 4; ++ni) acc[mi][ni] = MFMA16(bfr[0][ni], af[0][mi], acc[mi][ni]);
        __builtin_amdgcn_sched_barrier(0);
#pragma unroll
        for (int mi = 0; mi < 4; ++mi)
#pragma unroll
            for (int ni = 0; ni < 4; ++ni) acc[mi][ni] = MFMA16(bfr[1][ni], af[1][mi], acc[mi][ni]);
    }
}
DI bool xcd_next(int r, int total, int& it) {
    const int g = blockIdx.x & 7, lb = blockIdx.x >> 3, nb = gridDim.x >> 3, per = (total + 7) >> 3;
    const int idx = r * nb + lb;
    if (idx >= per) return false;
    it = g * per + idx;
    return true;
}
DI void zero_acc(f32x4 (&acc)[4][4]) {
#pragma unroll
    for (int mi = 0; mi < 4; ++mi)
#pragma unroll
        for (int ni = 0; ni < 4; ++ni) acc[mi][ni] = (f32x4){0.f, 0.f, 0.f, 0.f};
}

DI void phase_inproj(const Params& p, int layer, unsigned char* smem) {
    const int tid = otid(), lane = tid & 63, wave = tid >> 6, wr = wave >> 1, wc = wave & 1, l16 = lane & 15, fq = lane >> 4;
    const u16* H = (const u16*)(p.ws + OFF_H);
    const u16* W = (const u16*)(p.ws + OFF_WIN) + (size_t)layer * ZW * 1024;
    u16* Z = (u16*)(p.ws + OFF_Z);
    const float2* rope = (const float2*)(p.ws + OFF_ROPE);
    constexpr int NT = ZW / 128;
    for (int r = 0;; ++r) {
        int it; if (!xcd_next(r, 128 * NT, it)) break;
        if (it >= 128 * NT) continue;
        const int mt = it / NT, nt = it % NT, m0 = mt * 128, n0 = nt * 128;
        size_t aoff[4], boff[4];
#pragma unroll
        for (int i = 0; i < 4; ++i) { const int r = (wave * 4 + i) * 8 + ((tid >> 3) & 7); aoff[i] = (size_t)(m0 + r) * 1024; boff[i] = (size_t)(n0 + r) * 1024; }
        f32x4 acc[4][4]; zero_acc(acc);
        gemm_core(tid, H, aoff, W, boff, 1024, smem, acc);
#pragma unroll
        for (int ni = 0; ni < 4; ++ni) {
            const int cb = n0 + wc * 64 + ni * 16;
            if (cb >= ZC_END) continue;
            int op = 0;
            if (cb < 512 || (cb >= ZC_DQ && cb < ZC_KC) || (cb >= ZC_KS && cb < ZC_VS) || (cb >= ZC_KW && cb < ZC_VW)) op = ((cb & 63) == 0) ? 1 : 0;
            else if (cb >= ZC_AV && cb < ZC_IQ) op = 4;
            else if (cb >= ZC_IQ && cb < ZC_IW) op = ((cb & 31) == 0) ? 2 : 0;
            else if (cb >= ZC_BU && cb < ZC_CZ) op = 3;
            else if (cb >= ZC_VS && cb < ZC_KW) op = 5;
            else if (cb >= ZC_VW && cb < ZC_END) op = 6;
#pragma unroll
            for (int mi = 0; mi < 4; ++mi) {
                const int row = m0 + wr * 64 + mi * 16 + l16;
                f32x4 v = acc[mi][ni];
                if (op == 1) {
                    f32x4 pv; pv[0] = __shfl_xor(v[0], 32); pv[1] = __shfl_xor(v[1], 32); pv[2] = __shfl_xor(v[2], 32); pv[3] = __shfl_xor(v[3], 32);
                    const float2* cs = rope + (size_t)row * 8 + 4 * (fq & 1);
                    const float sgn = (fq < 2) ? -1.f : 1.f;
#pragma unroll
                    for (int j = 0; j < 4; ++j) { const float2 c2 = cs[j]; v[j] = v[j] * c2.x + sgn * pv[j] * c2.y; }
                } else if (op == 2) {
                    f32x4 pv; pv[0] = sxf<16>(v[0]); pv[1] = sxf<16>(v[1]); pv[2] = sxf<16>(v[2]); pv[3] = sxf<16>(v[3]);
                    if (fq < 2) {
                        const float2* cs = rope + (size_t)row * 8;
                        const float sgn = (fq == 0) ? -1.f : 1.f;
#pragma unroll
                        for (int j = 0; j < 4; ++j) { const float2 c2 = cs[2 * j]; v[j] = v[j] * c2.x + sgn * pv[j] * c2.y; }
                    }
                } else if (op == 3) {
#pragma unroll
                    for (int j = 0; j < 4; ++j) v[j] = gelu_tanh(v[j]);
                }
                if (op >= 4) {
                    const int b = row >> 12, t = row & 4095, tp = (t & ~15) | perm16(t & 15);
                    u16* vt; int ch;
                    if (op == 4) { ch = cb - ZC_AV + 4 * fq; vt = (u16*)(p.ws + OFF_VTA) + ((size_t)b * 256 + ch) * 4096; }
                    else if (op == 5) { ch = cb - ZC_VS + 4 * fq; vt = (u16*)(p.ws + OFF_VTS) + ((size_t)b * 64 + ch) * 4096; }
                    else { ch = cb - ZC_VW + 4 * fq; vt = (u16*)(p.ws + OFF_VTW) + ((size_t)b * 64 + ch) * 4096; }
#pragma unroll
                    for (int j = 0; j < 4; ++j) vt[(size_t)j * 4096 + tp] = f2bf(v[j]);
                } else {
                    uint2 pk; pk.x = pack2(v[0], v[1]); pk.y = pack2(v[2], v[3]);
                    if (cb >= ZC_IK && cb < ZC_IW) *(uint2*)((u16*)(p.ws + OFF_IKC) + (size_t)row * 32 + (cb - ZC_IK) + 4 * fq) = pk;
                    else *(uint2*)(Z + (size_t)row * ZW + cb + 4 * fq) = pk;
                }
            }
        }
    }
}

DI void phase_outproj(const Params& p, int layer, unsigned char* smem) {
    const int tid = otid(), lane = tid & 63, wave = tid >> 6, wr = wave >> 1, wc = wave & 1, l16 = lane & 15, fq = lane >> 4;
    const u16* Cc = (const u16*)(p.ws + OFF_CONCAT);
    const u16* W = (const u16*)(p.ws + OFF_WOUT) + (size_t)layer * 1024 * 1024;
    const float* mod = (const float*)(p.ws + OFF_MOD);
    for (int r = 0;; ++r) {
        int it; if (!xcd_next(r, 128 * 8, it)) break;
        if (it >= 128 * 8) continue;
        const int mt = it >> 3, nt = it & 7, m0 = mt * 128, n0 = nt * 128;
        size_t aoff[4], boff[4];
#pragma unroll
        for (int i = 0; i < 4; ++i) { const int r = (wave * 4 + i) * 8 + ((tid >> 3) & 7); aoff[i] = (size_t)(m0 + r) * 1024; boff[i] = (size_t)(n0 + r) * 1024; }
        f32x4 acc[4][4]; zero_acc(acc);
        gemm_core(tid, Cc, aoff, W, boff, 1024, smem, acc);
        const int b = m0 >> 12;
        const float* gate = mod + (size_t)(layer * 4 + b) * 6144 + 2 * 1024;
#pragma unroll
        for (int ni = 0; ni < 4; ++ni) {
            const int col = n0 + wc * 64 + ni * 16 + 4 * fq;
            const float4 g = *(const float4*)(gate + col);
#pragma unroll
            for (int mi = 0; mi < 4; ++mi) {
                const size_t o = (size_t)(m0 + wr * 64 + mi * 16 + l16) * 1024 + col;
                const float4 xv = (layer == 0) ? *(const float4*)(p.x + o) : ld_res4(res_row(p.out, m0 + wr * 64 + mi * 16 + l16) + col);
                float4 r; r.x = xv.x + g.x * acc[mi][ni][0]; r.y = xv.y + g.y * acc[mi][ni][1]; r.z = xv.z + g.z * acc[mi][ni][2]; r.w = xv.w + g.w * acc[mi][ni][3];
                st_res4(res_row(p.out, m0 + wr * 64 + mi * 16 + l16) + col, r.x, r.y, r.z, r.w);
            }
        }
    }
}

DI void cls_decode(int cls, int& e0, int& e1) {
    const int g = cls / 6, pi = cls % 6;
    const int lo = pi < 3 ? 0 : (pi < 5 ? 1 : 2);
    const int hi = pi < 3 ? pi + 1 : (pi < 5 ? pi - 1 : 3);
    e0 = g * 4 + lo; e1 = g * 4 + hi;
}
DI void phase_moe_gu(const Params& p, int layer, unsigned char* smem) {
    int* srow = (int*)(smem + GEMM_LDS);
    const int tid = otid(), lane = tid & 63, wave = tid >> 6, wr = wave >> 1, wc = wave & 1, l16 = lane & 15, fq = lane >> 4;
    const int* cnt = (const int*)(p.ws + OFF_CNT) + layer * 32;
    const u16* H = (const u16*)(p.ws + OFF_H);
    u16* HID = (u16*)(p.ws + OFF_HID);
    const float2* tokw = (const float2*)(p.ws + OFF_TOKW);
    int total = 0;
    for (int c = 0; c < NCLS; ++c) total += (cnt[c] + 127) >> 7;
    for (int r = 0;; ++r) {
        int it; if (!xcd_next(r, total * 8, it)) break;
        if (it >= total * 8) continue;
        int tile = it >> 3; const int slot = (it >> 2) & 1, nt = it & 3;
        int cls = 0;
        for (int c = 0; c < NCLS; ++c) { const int n = (cnt[c] + 127) >> 7; if (tile < n) { cls = c; break; } tile -= n; }
        const int nvalid = min(128, cnt[cls] - tile * 128);
        const int* list = (const int*)(p.ws + OFF_LIST) + (size_t)(layer * NCLS + cls) * NTOK + tile * 128;
        __syncthreads();
        if (tid < 128) srow[tid] = (tid < nvalid) ? list[tid] : -1;
        __syncthreads();
        int e0, e1; cls_decode(cls, e0, e1);
        const int ex = slot ? e1 : e0;
        size_t aoff[4], boff[4];
#pragma unroll
        for (int i = 0; i < 4; ++i) { const int rr = (wave * 4 + i) * 8 + ((tid >> 3) & 7); const int r = srow[rr]; aoff[i] = (size_t)(r < 0 ? 0 : r) * 1024; boff[i] = (size_t)rr * 1024; }
        f32x4 acc[4][4]; zero_acc(acc);
        gemm_core(tid, H, aoff, (const u16*)(p.ws + OFF_WGU) + ((size_t)(layer * 16 + ex) * 512 + nt * 128) * 1024, boff, 1024, smem, acc);
#pragma unroll
        for (int mi = 0; mi < 4; ++mi) {
            const int tok = srow[wr * 64 + mi * 16 + l16];
            if (tok < 0) continue;
            const float2 tw = tokw[tok];
            const float rw = slot ? tw.y : tw.x;
#pragma unroll
            for (int pr = 0; pr < 2; ++pr) {
                const f32x4 g = acc[mi][2 * pr], u = acc[mi][2 * pr + 1];
                float hv[4];
#pragma unroll
                for (int j = 0; j < 4; ++j) hv[j] = (g[j] / (1.f + __expf(-g[j]))) * u[j] * rw;
                const int hcol = nt * 64 + wc * 32 + pr * 16 + 4 * fq;
                uint2 pk; pk.x = pack2(hv[0], hv[1]); pk.y = pack2(hv[2], hv[3]);
                *(uint2*)(HID + ((size_t)tok * 2 + slot) * 256 + hcol) = pk;
            }
        }
    }
}
template <bool DUMMY> DI void phase_moe_down(const Params& p, int layer, unsigned char* smem) {
    int* srow = (int*)(smem + GEMM_LDS);
    const int tid = otid(), lane = tid & 63, wave = tid >> 6, wr = wave >> 1, wc = wave & 1, l16 = lane & 15, fq = lane >> 4;
    const int* cnt = (const int*)(p.ws + OFF_CNT) + layer * 32;
    const u16* HID = (const u16*)(p.ws + OFF_HID);
    const float* mod = (const float*)(p.ws + OFF_MOD);
    int total = 0;
    for (int c = 0; c < NCLS; ++c) total += (cnt[c] + 127) >> 7;
    for (int r = 0;; ++r) {
        int it; if (!xcd_next(r, total * 8, it)) break;
        if (it >= total * 8) continue;
        int tile = it >> 3; const int nt = it & 7;
        int cls = 0;
        for (int c = 0; c < NCLS; ++c) { const int n = (cnt[c] + 127) >> 7; if (tile < n) { cls = c; break; } tile -= n; }
        const int nvalid = min(128, cnt[cls] - tile * 128);
        const int* list = (const int*)(p.ws + OFF_LIST) + (size_t)(layer * NCLS + cls) * NTOK + tile * 128;
        __syncthreads();
        if (tid < 128) srow[tid] = (tid < nvalid) ? list[tid] : -1;
        __syncthreads();
        int e0, e1; cls_decode(cls, e0, e1);
        size_t aoff[4], boff[4];
#pragma unroll
        for (int i = 0; i < 4; ++i) { const int rr = (wave * 4 + i) * 8 + ((tid >> 3) & 7); const int r = srow[rr]; aoff[i] = (size_t)(r < 0 ? 0 : r) * 512; boff[i] = (size_t)rr * 256; }
        f32x4 acc[4][4]; zero_acc(acc);
        const u16* WD = (const u16*)(p.ws + OFF_WD);
        gemm_core(tid, HID, aoff, WD + ((size_t)(layer * 16 + e0) * 1024 + nt * 128) * 256, boff, 512, smem, acc,
                  HID + 256, WD + ((size_t)(layer * 16 + e1) * 1024 + nt * 128) * 256, 256);
#pragma unroll
        for (int mi = 0; mi < 4; ++mi) {
            const int tok = srow[wr * 64 + mi * 16 + l16];
            if (tok < 0) continue;
            const float* gate = mod + (size_t)(layer * 4 + (tok >> 12)) * 6144 + 5 * 1024;
#pragma unroll
            for (int ni = 0; ni < 4; ++ni) {
                const int col = nt * 128 + wc * 64 + ni * 16 + 4 * fq;
                const float4 g = *(const float4*)(gate + col);
                u16* o = res_row(p.out, tok) + col;
                float4 xv = ld_res4(o);
                xv.x += g.x * acc[mi][ni][0]; xv.y += g.y * acc[mi][ni][1]; xv.z += g.z * acc[mi][ni][2]; xv.w += g.w * acc[mi][ni][3];
                if (DUMMY) o = (u16*)(p.ws + OFF_PARK) + (((size_t)tok * 1024 + col) & 0x3FFFFFu);
                st_res4(o, xv.x, xv.y, xv.z, xv.w);
            }
        }
    }
}

DI void item_compress(const Params& p, int layer, int item, unsigned char* smem) {
    const int tid = otid(), lane = tid & 63, q = __builtin_amdgcn_readfirstlane(tid >> 6), l16 = lane & 15, fq = lane >> 4;
    const int b = item >> 5, kv = (item >> 4) & 1, g = item & 15, lk = layer * 2 + kv;
    u16* xs = (u16*)smem;
    float* part = (float*)(smem + 272 * 64 * 2);
    float* hid = part + 4096;
    float* ob = hid + 1024;
    float* cbs = ob + 1024;
    const u16* Z = (const u16*)(p.ws + OFF_Z) + (size_t)(b * SEQ) * ZW + (kv ? ZC_VC : ZC_KC);
    __syncthreads();
    if (tid < 64) {
        const float* cp = (const float*)(p.ws + OFF_CBIAS) + (size_t)lk * 64 * 64 + tid;
        float v[64];
#pragma unroll
        for (int j = 0; j < 64; ++j) v[j] = cp[j * 64];
        float a = 0.f;
#pragma unroll
        for (int j = 0; j < 64; ++j) a += v[j];
        cbs[tid] = a;
    }
    for (int i = tid; i < 272 * 8; i += 256) {
        const int r = i >> 3, c8 = (i & 7) * 8, tk = 256 * g + r;
        u32x4 v = {0u, 0u, 0u, 0u};
        if (tk < SEQ) v = *(const u32x4*)(Z + (size_t)tk * ZW + c8);
        *(u32x4*)(xs + r * 64 + c8) = v;
    }
    __syncthreads();
    {
        const u16* W = (const u16*)(p.ws + OFF_W1T) + (size_t)lk * 64 * 2048 + (size_t)l16 * 2048 + 8 * fq;
        f32x4 acc[4];
#pragma unroll
        for (int nt = 0; nt < 4; ++nt) acc[nt] = (f32x4){0.f, 0.f, 0.f, 0.f};
#pragma unroll 4
        for (int s_ = 0; s_ < 16; ++s_) {
            const int tkn = 8 * q + (s_ >> 1), h = s_ & 1, k0 = tkn * 64 + 32 * h;
            const bf16x8 afr = *(const bf16x8*)(xs + (16 * l16 + tkn) * 64 + 32 * h + 8 * fq);
#pragma unroll
            for (int nt = 0; nt < 4; ++nt) {
                const bf16x8 bfr = *(const bf16x8*)(W + (size_t)nt * 16 * 2048 + k0);
                acc[nt] = MFMA16(afr, bfr, acc[nt]);
            }
        }
#pragma unroll
        for (int nt = 0; nt < 4; ++nt)
#pragma unroll
            for (int r = 0; r < 4; ++r) part[(q * 16 + 4 * fq + r) * 64 + 16 * nt + l16] = acc[nt][r];
    }
    __syncthreads();
    {
        const float* cb = cbs;
#pragma unroll
        for (int i = 0; i < 4; ++i) { const int idx = tid + 256 * i; hid[idx] = gelu_tanh(part[idx] + part[1024 + idx] + part[2048 + idx] + part[3072 + idx] + cb[idx & 63]); }
    }
    __syncthreads();
    const int e = tid & 63, rq = tid >> 6;
    const float* w2 = p.w_cmp2 + (size_t)lk * 64 * 64 + e;
    float o[4] = {0.f, 0.f, 0.f, 0.f};
    {
        float wv[64];
#pragma unroll
        for (int k = 0; k < 64; ++k) wv[k] = w2[(size_t)k * 64];
#pragma unroll
        for (int k = 0; k < 64; ++k)
#pragma unroll
            for (int j = 0; j < 4; ++j) o[j] += hid[(4 * rq + j) * 64 + k] * wv[k];
    }
#pragma unroll
    for (int j = 0; j < 4; ++j) ob[(4 * rq + j) * 64 + e] = o[j];
    __syncthreads();
#pragma unroll
    for (int j = 0; j < 4; ++j) {
        const int r = 4 * rq + j, n = 16 * g + r;
        if (kv == 0) {
            u16* kc = (u16*)(p.ws + OFF_KCMP) + ((size_t)b * 256 + n) * 64;
            if (n < 255) {
                float rr = o[j];
                if (e < 16) {
                    const int tk = b * SEQ + 16 * n + 16;
                    const float2 cs = ((const float2*)(p.ws + OFF_ROPE))[(size_t)tk * 8 + (e & 7)];
                    const float other = ob[r * 64 + (e ^ 8)];
                    rr = (e < 8) ? o[j] * cs.x - other * cs.y : o[j] * cs.x + other * cs.y;
                }
                kc[e] = f2bf(rr);
            } else kc[e] = 0;
        } else {
            u16* vt = (u16*)(p.ws + OFF_VCMPT) + ((size_t)b * 64 + e) * 256;
            vt[(n & ~15) | perm16(n & 15)] = (n < 255) ? f2bf(o[j]) : (u16)0;
        }
    }
}

constexpr int TK_CAP = 32;
constexpr int TK_CAPL = 448;
constexpr int TK_FASTMIN = 4;
constexpr int TK_MARGIN = 36;
constexpr int TK_WLDS = 14848;
constexpr int TK_STG = 4 * TK_WLDS;
constexpr u32 TK_ZKEY = 0x80000000u;
constexpr int TK_MARGIN1 = 36;
DI void item_topk(const Params& p, int item, unsigned char* smem) {
    const int tid = otid(), lane = tid & 63, wave = tid >> 6, ql = lane >> 4, l16 = lane & 15;
    const int b = item >> 8, t0b = (item & 255) * 16, t0 = t0b + wave * 4, t = t0 + ql;
    u32* hist = (u32*)(smem + wave * TK_WLDS);
    u32* histB = hist + 1024;
    u32* lkey = hist;
    u16* lidx = (u16*)(smem + wave * TK_WLDS + 7168);
    u16* mrow = (u16*)(smem + wave * TK_WLDS + 10752);
    u16* mzero = (u16*)(smem + wave * TK_WLDS + 12800);
    u32* hist2 = (u32*)(smem + TK_STG + wave * 4096);
    u32* cand = histB;
    u16* stg = (u16*)(smem + TK_STG);
    const u16* zb = (const u16*)(p.ws + OFF_Z) + (size_t)(b * SEQ) * ZW;
    const u16* ikc = (const u16*)(p.ws + OFF_IKC) + (size_t)(b * SEQ) * 32;
    u64* maskT = (u64*)(p.ws + OFF_MASK) + (size_t)b * 64 * SEQ;
    const int nchunk = (t0b + 15) / 128 + 1;
    bool chk = false;
    __syncthreads();
    if (t0b < 256) {
        for (int st = 0; st < 256; ++st) {
            if (l16 == 0) { const int k0 = st * 16; const int nb = t - k0 + 1; mrow[ql * 256 + st] = (u16)(nb >= 16 ? 0xffffu : (nb <= 0 ? 0u : ((1u << nb) - 1u))); }
        }
    } else {
        const bf16x8 afr = *(const bf16x8*)(zb + (size_t)(t0 + (l16 >> 2)) * ZW + ZC_IQ + (l16 & 3) * 32 + 8 * (lane >> 4));
        const float w0 = bf2f(zb[(size_t)t * ZW + ZC_IW + 0]), w1 = bf2f(zb[(size_t)t * ZW + ZC_IW + 1]), w2 = bf2f(zb[(size_t)t * ZW + ZC_IW + 2]), w3 = bf2f(zb[(size_t)t * ZW + ZC_IW + 3]);
        auto score_keys = [&](const u16* st, u32 (&key)[8]) {
#pragma unroll
            for (int i = 0; i < 8; ++i) {
                const bf16x8 bfr = *(const bf16x8*)(st + (i * 16 + l16) * 32 + 8 * (lane >> 4));
                const f32x4 a = MFMA16(afr, bfr, ((f32x4){0.f, 0.f, 0.f, 0.f}));
                const float r0 = __int_as_float(max(__float_as_int(a[0]), 0)), r1 = __int_as_float(max(__float_as_int(a[1]), 0)), r2 = __int_as_float(max(__float_as_int(a[2]), 0)), r3 = __int_as_float(max(__float_as_int(a[3]), 0));
                float s = w0 * r0;
                s = fmaf(w1, r1, s); s = fmaf(w2, r2, s); s = fmaf(w3, r3, s);
                s += 0.f;
                const u32 u = __float_as_uint(s);
                key[i] = u ^ ((u >> 31) ? 0xffffffffu : 0x80000000u);
            }
        };
#define TK_SWEEP_BEGIN(CST) \
        { u32x4 r0 = *(const u32x4*)(ikc + (size_t)tid * 8), r1 = *(const u32x4*)(ikc + 2048 + (size_t)tid * 8); \
          *(u32x4*)(stg + tid * 8) = r0; *(u32x4*)(stg + 2048 + tid * 8) = r1; \
          __syncthreads(); \
          int sidx = 0; \
          for (int c = 0; c < nchunk; c += (CST)) { \
              if (c + (CST) < nchunk) { const u16* g = ikc + (size_t)(c + (CST)) * 4096 + tid * 8; r0 = *(const u32x4*)(g); r1 = *(const u32x4*)(g + 2048); } \
              u32 key[8]; score_keys(stg + sidx * 4096, key);
#define TK_SWEEP_END(CST) \
              if (c + (CST) < nchunk) { u16* d = stg + (sidx ^ 1) * 4096 + tid * 8; *(u32x4*)(d) = r0; *(u32x4*)(d + 2048) = r1; } \
              sidx ^= 1; \
              __syncthreads(); \
          } }
        const int tl = t - l16;
        auto find_bin = [&](const u32* hrow, u32 want, u32& Bq, u32& aq, u32& cq, u32& total) {
            const u32* hq = hrow + 16 * l16;
            u32 sblk = 0;
#pragma unroll
            for (int i = 0; i < 16; ++i) sblk += hq[i];
            u32 v = sblk;
            v += (u32)__builtin_amdgcn_update_dpp(0, (int)v, 0x101, 0xf, 0xf, true); v += (u32)__builtin_amdgcn_update_dpp(0, (int)v, 0x102, 0xf, 0xf, true);
            v += (u32)__builtin_amdgcn_update_dpp(0, (int)v, 0x104, 0xf, 0xf, true); v += (u32)__builtin_amdgcn_update_dpp(0, (int)v, 0x108, 0xf, 0xf, true);
            const u32 excl = v - sblk;
            total = (u32)__builtin_amdgcn_ds_swizzle((int)v, 0x10);
            const bool owner = (excl < want) && (want <= v);
            u32 Bo = 0, abo = 0, cdo = 0;
            if (owner) {
                u32 cum = excl; bool found = false;
                for (int i = 15; i >= 0; --i) { const u32 cn = hq[i]; if (!found && cum + cn >= want) { found = true; Bo = 16 * l16 + i; abo = cum; cdo = cn; } if (!found) cum += cn; }
            }
            const u64 om = __ballot(owner);
            const int srcl = 16 * ql + __builtin_ctz((u32)((om >> (16 * ql)) & 0xffffu) | 0x10000u);
            Bq = __shfl(Bo, srcl); aq = __shfl(abo, srcl); cq = __shfl(cdo, srcl);
        };
        bool listed = false;
        if (nchunk >= TK_FASTMIN) {
#pragma unroll 1
            for (int rp = 0; rp < 1 + (TKD & 1); ++rp) {
#pragma unroll
            for (int i = 0; i < 16; ++i) hist[lane + 64 * i] = 0;
            wave_lds_fence();
            TK_SWEEP_BEGIN(4)
#pragma unroll
                for (int i = 0; i < 8; ++i) if ((c * 128 + i * 16) <= tl) atomicAdd(&hist[ql * 256 + (key[i] >> 24)], 1u);
            TK_SWEEP_END(4)
            wave_lds_fence();
            }
            u32 Bh, Bl, ah, al, c_, tot;
            u32 tsum = 0;
            { const u32* hq = hist + ql * 256 + 16 * l16; u32 sb = 0;
#pragma unroll
              for (int i = 0; i < 16; ++i) sb += hq[i];
              sb += sxu<1>(sb); sb += sxu<2>(sb); sb += sxu<4>(sb); sb += sxu<8>(sb);
              tsum = sb; }
            const u32 rs = (256u * tsum) / (u32)(t + 1);
            const u32 r_hi = rs > (u32)TK_MARGIN1 ? rs - (u32)TK_MARGIN1 : 1u, r_lo = min(tsum, rs + (u32)TK_MARGIN1);
            find_bin(hist + ql * 256, r_hi, Bh, ah, c_, tot);
            find_bin(hist + ql * 256, r_lo, Bl, al, c_, tot);
            {
#pragma unroll
                for (int i = 0; i < 32; ++i) hist[lane + 64 * i] = 0;
                wave_lds_fence();
                int nsv = 0, nab = 0, nabl = 0;
#pragma unroll 1
                for (int rp = 0; rp < 1 + ((TKD >> 1) & 1); ++rp) {
                if (rp) {
                for (int i = 0; i < 32; ++i) hist[lane + 64 * i] = 0;
                wave_lds_fence(); nsv = 0; nab = 0; nabl = 0; }
                TK_SWEEP_BEGIN(2)
#pragma unroll
                    for (int i = 0; i < 8; ++i) {
                        const bool valid = (c * 128 + i * 16) <= tl;
                        const u32 tb = key[i] >> 24;
                        nsv += valid ? 1 : 0; nab += (valid & (tb > Bh)) ? 1 : 0; nabl += (valid & (tb > Bl)) ? 1 : 0;
                        if (valid & ((tb == Bh) | (tb == Bl))) atomicAdd(&hist[(tb == Bh ? 0 : 1024) + ql * 256 + ((key[i] >> 16) & 255u)], 1u);
                    }
                TK_SWEEP_END(2)
                wave_lds_fence();
                }
                nsv += sxi<1>(nsv); nsv += sxi<2>(nsv); nsv += sxi<4>(nsv); nsv += sxi<8>(nsv);
                nab += sxi<1>(nab); nab += sxi<2>(nab); nab += sxi<4>(nab); nab += sxi<8>(nab);
                nabl += sxi<1>(nabl); nabl += sxi<2>(nabl); nabl += sxi<4>(nabl); nabl += sxi<8>(nabl);
                const int rs2 = (int)((256u * (u32)nsv) / (u32)(t + 1));
                const int wh = rs2 - TK_MARGIN - nab, wl = rs2 + TK_MARGIN - nabl;
                const bool two = Bl != Bh;
                u32 bA, bD, a_, totH, totL;
                find_bin(hist + ql * 256, (u32)max(wh, 1), bA, a_, c_, totH);
                find_bin((two ? histB : hist) + ql * 256, (u32)max(wl, 1), bD, a_, c_, totL);
                const u32 hi16 = (Bh << 8) | (wh < 1 ? 255u : (wh <= (int)totH ? bA : 0u));
                const u32 lo16 = (Bl << 8) | (wl < 1 ? 255u : (wl <= (int)totL ? bD : 0u));
                wave_lds_fence();
                int ca = 0, cnt = 0, cz = 0;
#pragma unroll 1
                for (int rp = 0; rp < 1 + ((TKD >> 2) & 1); ++rp) {
                ca = 0; cnt = 0; cz = 0;
                TK_SWEEP_BEGIN(1)
                    u32 accA = 0u, accZ = 0u;
#pragma unroll
                    for (int i = 0; i < 8; ++i) {
                        const int st = c * 8 + i;
                        const bool valid = (st * 16) <= tl;
                        const u32 k16 = key[i] >> 16;
                        const bool above = valid & (k16 > hi16);
                        const bool isz = valid & (key[i] == TK_ZKEY);
                        const bool cd = valid & (k16 >= lo16) & !above & !isz;
                        accA |= above ? (1u << i) : 0u; accZ |= isz ? (1u << i) : 0u;
                        const u64 cb = __ballot(cd);
                        const u32 seg = (u32)((cb >> (16 * ql)) & 0xffffu);
                        const int pos = cnt + __popc(seg & ((1u << l16) - 1u));
                        if (cd && pos < TK_CAPL) { lkey[ql * TK_CAPL + pos] = key[i]; lidx[ql * TK_CAPL + pos] = (u16)(st * 16 + l16); }
                        cnt += __popc(seg);
                    }
                    ca += __popc(accA); cz += __popc(accZ);
                    ((unsigned char*)mrow)[ql * 512 + c * 16 + l16] = (unsigned char)accA;
                    ((unsigned char*)mzero)[ql * 512 + c * 16 + l16] = (unsigned char)accZ;
                TK_SWEEP_END(1)
                }
                wave_lds_fence();
#pragma unroll
                for (int mk = 0; mk < 2; ++mk) {
                    u32x4* base = (u32x4*)(mk ? mzero : mrow);
#pragma unroll
                    for (int pp = 0; pp < 2; ++pp) {
                        const int pr = lane + 64 * pp, cq = pr & 31;
                        u32x4 w = base[pr];
                        u32x4 o = {0u, 0u, 0u, 0u};
                        if (cq < nchunk) {
                            u64 x = (u64)w[0] | ((u64)w[1] << 32), y = (u64)w[2] | ((u64)w[3] << 32), t_;
                            t_ = (x ^ (x >> 7)) & 0x00AA00AA00AA00AAull; x = x ^ t_ ^ (t_ << 7);
                            t_ = (x ^ (x >> 14)) & 0x0000CCCC0000CCCCull; x = x ^ t_ ^ (t_ << 14);
                            t_ = (x ^ (x >> 28)) & 0x00000000F0F0F0F0ull; x = x ^ t_ ^ (t_ << 28);
                            t_ = (y ^ (y >> 7)) & 0x00AA00AA00AA00AAull; y = y ^ t_ ^ (t_ << 7);
                            t_ = (y ^ (y >> 14)) & 0x0000CCCC0000CCCCull; y = y ^ t_ ^ (t_ << 14);
                            t_ = (y ^ (y >> 28)) & 0x00000000F0F0F0F0ull; y = y ^ t_ ^ (t_ << 28);
#pragma unroll
                            for (int j = 0; j < 4; ++j) {
                                const u32 xl = (u32)(x >> (16 * j)) & 0xffffu, yl = (u32)(y >> (16 * j)) & 0xffffu;
                                o[j] = (xl & 0xffu) | ((yl & 0xffu) << 8) | ((xl >> 8) << 16) | ((yl >> 8) << 24);
                            }
                        }
                        base[pr] = o;
                    }
                }
                wave_lds_fence();
                ca += sxi<1>(ca); ca += sxi<2>(ca); ca += sxi<4>(ca); ca += sxi<8>(ca);
                cz += sxi<1>(cz); cz += sxi<2>(cz); cz += sxi<4>(cz); cz += sxi<8>(cz);
                const bool zin = (lo16 <= (TK_ZKEY >> 16)) && ((TK_ZKEY >> 16) <= hi16);
                const int czb = zin ? cz : 0;
                const bool ok = (ca < 256) && (256 <= ca + cnt + czb) && (cnt <= TK_CAPL);
                const int miss = block_or(ok ? 0 : 1, smem);
                if (!miss) {
                    listed = true;
                    wave_lds_fence();
                    int ncmax = cnt;
                    ncmax = max(ncmax, sxi<16>(ncmax)); ncmax = max(ncmax, __shfl_xor(ncmax, 32));
#pragma unroll 1
                    for (int rp = 0; rp < 1 + ((TKD >> 3) & 1); ++rp) {
                    int need2 = 256 - ca;
                    u32 pfx = 0;
                    int lv0 = 0;
                    const bool narrow = __ballot((hi16 - lo16) >= 256u) == 0ull;
                    if (narrow) {
#pragma unroll
                        for (int i = 0; i < 16; ++i) hist2[lane + 64 * i] = 0;
                        wave_lds_fence();
                        for (int e = l16; e < ncmax; e += 32) {
                            const bool v0 = e < cnt, v1 = e + 16 < cnt;
                            const u32 k0 = v0 ? lkey[ql * TK_CAPL + e] : 0u, k1 = v1 ? lkey[ql * TK_CAPL + e + 16] : 0u;
                            if (v0) atomicAdd(&hist2[ql * 256 + ((k0 >> 16) - lo16)], 1u);
                            if (v1) atomicAdd(&hist2[ql * 256 + ((k1 >> 16) - lo16)], 1u);
                        }
                        wave_lds_fence();
                        if (l16 == 0 && czb) hist2[ql * 256 + ((TK_ZKEY >> 16) - lo16)] += (u32)czb;
                        wave_lds_fence();
                        u32 Bq, aq, cq, tt;
                        find_bin(hist2 + ql * 256, (u32)need2, Bq, aq, cq, tt);
                        pfx = lo16 + Bq; need2 -= (int)aq;
                        lv0 = 2;
                    }
#pragma unroll 1
                    for (int lv = lv0; lv < 4; ++lv) {
                        const int sh = 24 - 8 * lv;
#pragma unroll
                        for (int i = 0; i < 16; ++i) hist2[lane + 64 * i] = 0;
                        wave_lds_fence();
                        for (int e = l16; e < ncmax; e += 32) {
                            const bool v0 = e < cnt, v1 = e + 16 < cnt;
                            const u32 k0 = v0 ? lkey[ql * TK_CAPL + e] : 0u, k1 = v1 ? lkey[ql * TK_CAPL + e + 16] : 0u;
                            if (v0 && (u32)((u64)k0 >> (sh + 8)) == pfx) atomicAdd(&hist2[ql * 256 + ((k0 >> sh) & 255u)], 1u);
                            if (v1 && (u32)((u64)k1 >> (sh + 8)) == pfx) atomicAdd(&hist2[ql * 256 + ((k1 >> sh) & 255u)], 1u);
                        }
                        wave_lds_fence();
                        if (l16 == 0 && czb && (u32)((u64)TK_ZKEY >> (sh + 8)) == pfx) hist2[ql * 256 + ((TK_ZKEY >> sh) & 255u)] += (u32)czb;
                        wave_lds_fence();
                        u32 Bq, aq, cq, tt;
                        find_bin(hist2 + ql * 256, (u32)need2, Bq, aq, cq, tt);
                        pfx = (pfx << 8) | Bq; need2 -= (int)aq;
                    }
                    int run = 0;
                    for (int base = 0; base < ncmax; base += 16) {
                        const int e = base + l16;
                        const bool v = e < cnt;
                        const u32 k = v ? lkey[ql * TK_CAPL + e] : 0u, idx = v ? (u32)lidx[ql * TK_CAPL + e] : 0u;
                        const bool eq = v && (k == pfx);
                        const u64 eb = __ballot(eq);
                        const u32 seg = (u32)((eb >> (16 * ql)) & 0xffffu);
                        const bool sel = (v && k > pfx) || (eq && (run + __popc(seg & ((1u << l16) - 1u))) < need2);
                        run += __popc(seg);
                        if (sel) atomicOr((u32*)(mrow + ql * 256) + (idx >> 5), 1u << (idx & 31));
                    }
                    {
                        const int ztake = !czb ? 0 : (pfx < TK_ZKEY ? czb : (pfx == TK_ZKEY ? need2 : 0));
                        const int anyz = ztake;
                        int az = anyz; az = max(az, sxi<16>(az)); az = max(az, __shfl_xor(az, 32));
                        if (az) {
                            const u32* mz32 = (const u32*)(mzero + ql * 256) + l16 * 8;
                            u32 w[8]; int pc = 0;
#pragma unroll
                            for (int i = 0; i < 8; ++i) { w[i] = mz32[i]; pc += __popc(w[i]); }
                            int incl = pc;
                            incl += __builtin_amdgcn_update_dpp(0, incl, 0x111, 0xf, 0xf, true); incl += __builtin_amdgcn_update_dpp(0, incl, 0x112, 0xf, 0xf, true);
                            incl += __builtin_amdgcn_update_dpp(0, incl, 0x114, 0xf, 0xf, true); incl += __builtin_amdgcn_update_dpp(0, incl, 0x118, 0xf, 0xf, true);
                            int before = incl - pc;
                            u32* mr32 = (u32*)(mrow + ql * 256) + l16 * 8;
#pragma unroll
                            for (int i = 0; i < 8; ++i) {
                                int room = ztake - before;
                                u32 m = w[i];
                                const int c = __popc(m);
                                if (room < c) { int drop = c - max(room, 0); while (drop > 0) { m &= ~(0x80000000u >> __builtin_clz(m)); --drop; } }
                                if (m) mr32[i] |= m;
                                before += c;
                            }
                        }
                    }
                    }
                }
            }
        }
#if TKCHECK
        chk = listed;
        if (listed) { wave_lds_fence(); const u64* m64c = (const u64*)mrow;
            for (int qq = 0; qq < 4; ++qq) maskT[(size_t)lane * SEQ + t0 + qq] = m64c[qq * 64 + lane];
            wave_lds_fence(); if (lane == 0) atomicAdd((int*)(p.ws + OFF_CNT) + 101, 1); }
        __syncthreads();
#endif
        if (!listed || TKCHECK) {
        u32 prefix = 0; int need = 256; int shift = 32, shift_prev = 32; int lvl = 0;
        for (;;) {
            shift = 24 - 8 * lvl;
#pragma unroll
            for (int i = 0; i < 16; ++i) hist[lane + 64 * i] = 0;
            wave_lds_fence();
            TK_SWEEP_BEGIN(1)
#pragma unroll
                for (int i = 0; i < 8; ++i) {
                    const bool match = ((c * 128 + i * 16) <= tl) & ((u32)((u64)key[i] >> shift_prev) == prefix);
                    if (match) atomicAdd(&hist[ql * 256 + ((key[i] >> shift) & 255u)], 1u);
                }
            TK_SWEEP_END(1)
            wave_lds_fence();
            u32 Bq, aq, cq, tot;
            find_bin(hist + ql * 256, (u32)need, Bq, aq, cq, tot);
            prefix = (prefix << 8) | Bq; need -= (int)aq;
            const int more = block_or((lvl < 3 && cq > (u32)TK_CAP) ? 1 : 0, smem);
            if (!more) break;
            ++lvl; shift_prev = shift;
        }
        const bool exact = (lvl == 3);
        int run = 0, ccount = 0;
        TK_SWEEP_BEGIN(1)
#pragma unroll
            for (int i = 0; i < 8; ++i) {
                const int st = c * 8 + i;
                const bool valid = (st * 16) <= tl;
                const u32 kp = exact ? key[i] : (key[i] >> shift);
                const bool hi = valid && kp > prefix, cd = valid && kp == prefix;
                const u64 cb = __ballot(cd);
                const u32 seg = (u32)((cb >> (16 * ql)) & 0xffffu);
                const int below = __popc(seg & ((1u << l16) - 1u));
                bool sel = hi;
                if (exact) { sel = hi || (cd && (run + below) < need); run += __popc(seg); }
                else { if (cd) { const int pos = ccount + below; if (pos < TK_CAP) { cand[(ql * TK_CAP + pos) * 2] = key[i]; cand[(ql * TK_CAP + pos) * 2 + 1] = (u32)(st * 16 + l16); } } ccount += __popc(seg); }
                const u64 sb = __ballot(sel);
                if (l16 == 0) mrow[ql * 256 + st] = (u16)((sb >> (16 * ql)) & 0xffffu);
            }
        TK_SWEEP_END(1)
        for (int st = nchunk * 8 + (lane & 15); st < 256; st += 16) mrow[ql * 256 + st] = 0;
        wave_lds_fence();
        if (!exact) {
            const int n = min(ccount, TK_CAP);
            for (int c = l16; c < n; c += 16) {
                const u32 k = cand[(ql * TK_CAP + c) * 2], idx = cand[(ql * TK_CAP + c) * 2 + 1];
                int rank = 0;
                for (int c2 = 0; c2 < n; ++c2) { const u32 k2 = cand[(ql * TK_CAP + c2) * 2]; rank += (k2 > k || (k2 == k && c2 < c)) ? 1 : 0; }
                if (rank < need) atomicOr((u32*)(mrow + ql * 256) + (idx >> 5), 1u << (idx & 31));
            }
        }
        }
    }
    wave_lds_fence();
    const u64* m64 = (const u64*)mrow;
#if TKCHECK
    if (chk) { bool diff = false;
        for (int qq = 0; qq < 4; ++qq) diff |= maskT[(size_t)lane * SEQ + t0 + qq] != m64[qq * 64 + lane];
        if (diff) atomicOr((int*)(p.ws + OFF_CNT) + 100, 1); }
#endif
    (void)m64;
    __syncthreads();
#pragma unroll
    for (int i = 0; i < 4; ++i) {
        const int kt = wave * 16 + i * 4 + ql;
        const u64* src = (const u64*)(smem + (l16 >> 2) * TK_WLDS + 10752);
        maskT[(size_t)kt * SEQ + t0b + l16] = src[(l16 & 3) * 64 + kt];
    }
    wave_lds_fence();
}

DI void item_gmlp(const Params& p, int layer, int item, unsigned char* smem) {
    const int tid = otid(), lane = tid & 63, wave = tid >> 6, l16 = lane & 15, fq = lane >> 4;
    const int T0 = item * 128;
    u16* vnT = (u16*)smem;
    float2* stat = (float2*)(smem + 2 * 64 * 136 * 2);
    const u16* Z = (const u16*)(p.ws + OFF_Z);
    u16* CC = (u16*)(p.ws + OFF_CONCAT);
    __syncthreads();
    {
        const int s = tid >> 1, half = tid & 1;
        const uint4* src = (const uint4*)(Z + (size_t)(T0 + s) * ZW + ZC_BV + 128 * half);
        float sm = 0.f, sq = 0.f;
#pragma unroll
        for (int i = 0; i < 16; ++i) { const uint4 q = src[i]; const u32 w[4] = {q.x, q.y, q.z, q.w};
#pragma unroll
            for (int j = 0; j < 4; ++j) { const float a = __uint_as_float(w[j] << 16), c = __uint_as_float(w[j] & 0xffff0000u); sm += a + c; sq += a * a + c * c; } }
        sm += sxf<1>(sm); sq += sxf<1>(sq);
        const float mu = sm * (1.f / 256.f), var = fmaxf(sq * (1.f / 256.f) - mu * mu, 0.f);
        if (half == 0) { float2 st; st.x = mu; st.y = rsqrtf(var + 1e-6f); stat[s] = st; }
    }
    __syncthreads();
    const u16* WS = (const u16*)(p.ws + OFF_WSGU) + (size_t)layer * 4 * 128 * 128;
    for (int rd = 0; rd < 2; ++rd) {
        for (int i = tid; i < 128 * 16; i += 256) {
            const int s = i >> 4, c8 = (i & 15) * 8, ch = rd * 128 + c8;
            const uint4 q = *(const uint4*)(Z + (size_t)(T0 + s) * ZW + ZC_BV + ch);
            const float2 st = stat[s];
            const u32 w[4] = {q.x, q.y, q.z, q.w};
#pragma unroll
            for (int j = 0; j < 4; ++j) {
                const float a = __uint_as_float(w[j] << 16), c = __uint_as_float(w[j] & 0xffff0000u);
                const float g0 = p.sgu_g[layer * 256 + ch + 2 * j], g1 = p.sgu_g[layer * 256 + ch + 2 * j + 1];
                vnT[(size_t)(c8 + 2 * j) * 136 + s] = f2bf((a - st.x) * st.y * g0);
                vnT[(size_t)(c8 + 2 * j + 1) * 136 + s] = f2bf((c - st.x) * st.y * g1);
            }
        }
        __syncthreads();
        const int hh = wave & 1, th = wave >> 1, hd = 2 * rd + hh;
        f32x4 acc[4][4]; zero_acc(acc);
        const u16* Wh = WS + (size_t)hd * 128 * 128;
#pragma unroll
        for (int ti = 0; ti < 4; ++ti) {
            const int tb = 64 * th + 16 * ti;
            bf16x8 wf[4];
#pragma unroll
            for (int ks = 0; ks < 4; ++ks) wf[ks] = *(const bf16x8*)(Wh + (size_t)(tb + l16) * 128 + ks * 32 + 8 * fq);
#pragma unroll
            for (int ks = 0; ks < 4; ++ks) {
                if (ks * 32 >= tb + 16) continue;
#pragma unroll
                for (int di = 0; di < 4; ++di) {
                    const bf16x8 vf = *(const bf16x8*)(vnT + (size_t)(hh * 64 + di * 16 + l16) * 136 + ks * 32 + 8 * fq);
                    acc[ti][di] = MFMA16(vf, wf[ks], acc[ti][di]);
                }
            }
        }
#pragma unroll
        for (int ti = 0; ti < 4; ++ti) {
            const int tl = 64 * th + 16 * ti + l16;
            const float bias = p.b_sgu[(size_t)(layer * 4 + hd) * 128 + tl];
#pragma unroll
            for (int di = 0; di < 4; ++di) {
                const int d = di * 16 + 4 * fq;
                const uint2 uq = *(const uint2*)(Z + (size_t)(T0 + tl) * ZW + ZC_BU + hd * 64 + d);
                const float u0 = __uint_as_float(uq.x << 16), u1 = __uint_as_float(uq.x & 0xffff0000u), u2 = __uint_as_float(uq.y << 16), u3 = __uint_as_float(uq.y & 0xffff0000u);
                uint2 pk; pk.x = pack2(u0 * (acc[ti][di][0] + bias), u1 * (acc[ti][di][1] + bias)); pk.y = pack2(u2 * (acc[ti][di][2] + bias), u3 * (acc[ti][di][3] + bias));
                *(uint2*)(CC + (size_t)(T0 + tl) * 1024 + 256 + hd * 64 + d) = pk;
            }
        }
        __syncthreads();
    }
}

DI void item_pool(const Params& p, int layer, int item, unsigned char* smem) {
    const int tid = otid(), lane = tid & 63, wave = __builtin_amdgcn_readfirstlane(tid >> 6), l16 = lane & 15, fq = lane >> 4;
    const int T0 = item * 64, tseq0 = T0 & 4095;
    float* zt = (float*)smem;
    u16* Pb = (u16*)(smem + 79 * 64 * 4);
    u16* Wt = Pb + 64 * 72;
    const u16* Z = (const u16*)(p.ws + OFF_Z);
    u16* CC = (u16*)(p.ws + OFF_CONCAT);
    for (int g = 0; g < 4; ++g) {
        const int w = 2 << g;
        __syncthreads();
        for (int i = tid; i < 79 * 8; i += 256) {
            const int r = i >> 3, c8 = (i & 7) * 8, ts = tseq0 - 15 + r;
            u32x4 q = {0u, 0u, 0u, 0u};
            if (ts >= 0) q = *(const u32x4*)(Z + (size_t)(T0 - 15 + r) * ZW + ZC_CZ + g * 64 + c8);
#pragma unroll
            for (int j = 0; j < 4; ++j) { zt[r * 64 + c8 + 2 * j] = __uint_as_float(q[j] << 16); zt[r * 64 + c8 + 2 * j + 1] = __uint_as_float(q[j] & 0xffff0000u); }
        }
        {
            const f32x4* wsrc = (const f32x4*)(p.w_pool + (size_t)(layer * 4 + g) * 64 * 64);
#pragma unroll
            for (int i = 0; i < 4; ++i) {
                const int idx = tid + 256 * i, c = idx >> 4, e4 = (idx & 15) * 4;
                const f32x4 v = wsrc[idx];
#pragma unroll
                for (int j = 0; j < 4; ++j) Wt[(e4 + j) * 72 + c] = f2bf(v[j]);
            }
        }
        __syncthreads();
#define POOL_MEAN(W) \
        for (int i = tid; i < 64 * 64; i += 256) { \
            const int tl = i >> 6, c = i & 63, ts = tseq0 + tl; \
            const int cntw = min(ts + 1, (W)); \
            float sacc = 0.f; \
            _Pragma("unroll") for (int k = 0; k < (W); ++k) sacc += zt[(tl + 15 - k) * 64 + c]; \
            Pb[tl * 72 + c] = f2bf(sacc / (float)cntw - zt[(tl + 15) * 64 + c]); \
        }
        if (g == 0) { POOL_MEAN(2) } else if (g == 1) { POOL_MEAN(4) } else if (g == 2) { POOL_MEAN(8) } else { POOL_MEAN(16) }
#undef POOL_MEAN
        __syncthreads();
        f32x4 acc[4];
#pragma unroll
        for (int nt = 0; nt < 4; ++nt) acc[nt] = (f32x4){0.f, 0.f, 0.f, 0.f};
#pragma unroll
        for (int ks = 0; ks < 2; ++ks) {
            const bf16x8 afr = *(const bf16x8*)(Pb + (16 * wave + l16) * 72 + ks * 32 + 8 * fq);
#pragma unroll
            for (int nt = 0; nt < 4; ++nt) {
                const bf16x8 bfr = *(const bf16x8*)(Wt + (16 * nt + l16) * 72 + ks * 32 + 8 * fq);
                acc[nt] = MFMA16(bfr, afr, acc[nt]);
            }
        }
#pragma unroll
        for (int nt = 0; nt < 4; ++nt) {
            const int e0 = 16 * nt + 4 * fq;
            const f32x4 sc = *(const f32x4*)(p.pool_scale + layer * 256 + g * 64 + e0);
            uint2 pk; pk.x = pack2(acc[nt][0] * sc[0], acc[nt][1] * sc[1]); pk.y = pack2(acc[nt][2] * sc[2], acc[nt][3] * sc[3]);
            *(uint2*)(CC + (size_t)(T0 + 16 * wave + l16) * 1024 + 512 + g * 64 + e0) = pk;
        }
    }
}

constexpr int P2A_CMP = 128, P2A_TOPK = 1024, P2A_GMLP = 128, P2A_POOL = 256;
#ifndef REP2
#define REP2 0
#endif
DI int next_item(int* ctr, unsigned char* smem) {
    volatile int* slot = (volatile int*)(smem + SMEM_BYTES - 16);
    __syncthreads();
    if (threadIdx.x == 0) *slot = atomicAdd(ctr, 1);
    __syncthreads();
    return *slot;
}
DI void phase_mix_a(const Params& p, int layer, unsigned char* smem) {
    const int G = (int)gridDim.x, bid = (int)blockIdx.x;
    const int nwt = (layer == 0) ? WT_A : 0;
    const bool xaff = (G == 512);
    int* ctr = (int*)(p.ws + OFF_CNT) + 64 + layer * 2;
    const int nstat = (P2A_TOPK / 2 - bid + G - 1) / G;
    const bool swp = (SWAPMODE == 1) ? (bid >= (G >> 1)) : ((SWAPMODE == 2) ? ((bid & 1) != 0) : false);
#pragma unroll 1
    for (int s_ = 0; s_ < 3; ++s_) {
        const int stage = s_ ^ ((swp && s_ < 2) ? 1 : 0);
        if (stage == 0) {
            for (int it0 = bid; it0 < P2A_GMLP + P2A_POOL + P2A_CMP; it0 += G) {
                int it = it0;
                if (xaff) {
                    const int xg = bid & 7, xlb = bid >> 3;
                    if (xlb < 16) it = xg * 16 + xlb;
                    else if (xlb < 48) it = P2A_GMLP + xg * 32 + (xlb - 16);
                    else { const int j = xlb - 48; it = P2A_GMLP + P2A_POOL + (((xg >> 1) << 5) | ((j >> 3) << 4) | ((xg & 1) * 8 + (j & 7))); }
                }
                if (it < P2A_GMLP) {
#pragma unroll 1
                    for (int rep = 0; rep < 1 + ((REP2 >> 2) & 1); ++rep) item_gmlp(p, layer, it, smem);
                } else if ((it -= P2A_GMLP) < P2A_POOL) {
#pragma unroll 1
                    for (int rep = 0; rep < 1 + ((REP2 >> 3) & 1); ++rep) item_pool(p, layer, it, smem);
                } else {
                    it -= P2A_POOL;
#pragma unroll 1
                    for (int rep = 0; rep < 1 + ((REP2 >> 1) & 1); ++rep) item_compress(p, layer, it, smem);
                }
            }
            for (int it = G - 1 - bid; it < nwt; it += G) {
                const int tidw = otid();
#pragma unroll 1
                for (int k = 0; k < 8; k += 4) wtile4(p, wt_tile_a(it * 8 + k), wt_tile_a(it * 8 + k + 1), wt_tile_a(it * 8 + k + 2), wt_tile_a(it * 8 + k + 3), smem, tidw);
            }
            if (layer == 0) {
                for (int it = bid; it < P0_MOD - P0_MOD_NOW; it += G) mod_item(p, P0_MOD_NOW + it, smem, otid());
            }
        } else {
            const bool dyn = stage == 2;
            for (int k = 0;; ++k) {
                int it;
                if (dyn) it = P2A_TOPK / 2 + next_item(ctr, smem);
                else { if (k >= nstat) break; it = bid + k * G; }
                if (it >= P2A_TOPK) break;
                const int b = it & 3, g = 255 - (it >> 2);
#pragma unroll 1
                for (int rep = 0; rep < 1 + (REP2 & 1); ++rep) item_topk(p, b * 256 + g, smem);
            }
        }
    }
}

constexpr float LOG2E = 1.4426950408889634f;
constexpr int SROW = 72;
constexpr int STAGE_U16 = 2 * 64 * SROW;
struct TileRegs { u32x4 k0, k1, v0, v1; };
DI void tile_fetch(TileRegs& r, int tid, const u16* __restrict__ Kt, int kld, const u16* __restrict__ Vt, int vld) {
    const int row = tid >> 3, ch = (tid & 7) * 8;
    r.k0 = *(const u32x4*)(Kt + (size_t)row * kld + ch); r.k1 = *(const u32x4*)(Kt + (size_t)(row + 32) * kld + ch);
    r.v0 = *(const u32x4*)(Vt + (size_t)row * vld + ch); r.v1 = *(const u32x4*)(Vt + (size_t)(row + 32) * vld + ch);
}
DI void tile_store(const TileRegs& r, int tid, u16* st) {
    const int row = tid >> 3, ch = (tid & 7) * 8;
    *(u32x4*)(st + row * SROW + ch) = r.k0; *(u32x4*)(st + (row + 32) * SROW + ch) = r.k1;
    *(u32x4*)(st + 64 * SROW + row * SROW + ch) = r.v0; *(u32x4*)(st + 64 * SROW + (row + 32) * SROW + ch) = r.v1;
}
template <class MaskF>
DI void flash_tile(const int lane, const u16* st, const bf16x8 (&qf)[4], f32x16& O0, f32x16& O1, float& m, float& l, MaskF maskf) {
    const int r31 = lane & 31, h = lane >> 5;
    const u16* sK = st + r31 * SROW + 8 * h; const u16* sV = st + 64 * SROW + r31 * SROW + 8 * h;
    f32x16 S0, S1;
#pragma unroll
    for (int i = 0; i < 16; ++i) { S0[i] = 0.f; S1[i] = 0.f; }
#pragma unroll
    for (int kk = 0; kk < 4; ++kk) {
        const bf16x8 k0f = *(const bf16x8*)(sK + kk * 16);
        const bf16x8 k1f = *(const bf16x8*)(sK + 32 * SROW + kk * 16);
        S0 = MFMA32(k0f, qf[kk], S0); S1 = MFMA32(k1f, qf[kk], S1);
    }
    asm volatile("" ::: "memory");
    float mx = -INFINITY;
    float pinf = INFINITY; asm volatile("" : "+s"(pinf));
#pragma unroll
    for (int r = 0; r < 16; ++r) {
        const int c = (r & 3) + 8 * (r >> 2);
        S0[r] = maskf(0, c, S0[r]);
        S1[r] = maskf(1, c, S1[r]);
        mx = __builtin_amdgcn_fmed3f(mx, S0[r], pinf); mx = __builtin_amdgcn_fmed3f(mx, S1[r], pinf);
    }
    mx = fmaxf(mx, __shfl_xor(mx, 32));
    const float mnew = fmaxf(m, mx);
    float ps = 0.f;
#pragma unroll
    for (int r = 0; r < 16; ++r) {
        const float p0 = __builtin_amdgcn_exp2f(S0[r] - mnew), p1 = __builtin_amdgcn_exp2f(S1[r] - mnew);
        S0[r] = p0; S1[r] = p1; ps += p0 + p1;
    }
    if (__ballot(mnew > m) != 0) {
        const float alpha = __builtin_amdgcn_exp2f(m - mnew);
        l *= alpha;
#pragma unroll
        for (int i = 0; i < 16; ++i) { O0[i] *= alpha; O1[i] *= alpha; }
    }
    m = mnew;
    l += ps;
#pragma unroll
    for (int G = 0; G < 4; ++G) {
        u32x4 pw;
#pragma unroll
        for (int j = 0; j < 4; ++j) {
            const int r = (G & 1) * 8 + 2 * j;
            pw[j] = (G < 2) ? pack2(S0[r], S0[r + 1]) : pack2(S1[r], S1[r + 1]);
        }
        const bf16x8 pfv = __builtin_bit_cast(bf16x8, pw);
        const bf16x8 v0 = *(const bf16x8*)(sV + 16 * G);
        const bf16x8 v1 = *(const bf16x8*)(sV + 32 * SROW + 16 * G);
        O0 = MFMA32(v0, pfv, O0); O1 = MFMA32(v1, pfv, O1);
    }
}
DI void load_q(const u16* qrow, bf16x8 (&qf)[4]) {
#pragma unroll
    for (int kk = 0; kk < 4; ++kk) {
        bf16x8 t = *(const bf16x8*)(qrow + kk * 16);
#pragma unroll
        for (int j = 0; j < 8; ++j) t[j] = (short)f2bf(bf2f((u16)t[j]) * (0.125f * LOG2E));
        qf[kk] = t;
    }
}
DI void zero16(f32x16& a) {
#pragma unroll
    for (int i = 0; i < 16; ++i) a[i] = 0.f;
}
DI void store_o(u16* orow, const f32x16& O0, const f32x16& O1, int h) {
#pragma unroll
    for (int i = 0; i < 4; ++i) {
        uint2 a; a.x = pack2(O0[4 * i], O0[4 * i + 1]); a.y = pack2(O0[4 * i + 2], O0[4 * i + 3]);
        *(uint2*)(orow + 8 * i + 4 * h) = a;
        uint2 c; c.x = pack2(O1[4 * i], O1[4 * i + 1]); c.y = pack2(O1[4 * i + 2], O1[4 * i + 3]);
        *(uint2*)(orow + 32 + 8 * i + 4 * h) = c;
    }
}

DI void item_dsa_attn(const Params& p, int item, unsigned char* smem) {
    const int tid = otid(); const int lane = tid & 63, wave = tid >> 6, r31 = lane & 31, h = lane >> 5;
    const int b = item >> 7, hd = (item >> 5) & 3, qb = (item & 31) * 128, q0 = qb + wave * 32;
    u16* stg = (u16*)smem;
    const u16* Z = (const u16*)(p.ws + OFF_Z) + (size_t)(b * SEQ) * ZW;
    const u16* Kb = Z + ZC_AK + hd * 64;
    const u16* Vt = (const u16*)(p.ws + OFF_VTA) + (size_t)(b * 4 + hd) * 64 * SEQ;
    const u64* maskT = (const u64*)(p.ws + OFF_MASK) + (size_t)b * 64 * SEQ + q0 + r31;
    bf16x8 qf[4]; load_q(Z + (size_t)(q0 + r31) * ZW + ZC_AQ + hd * 64 + 8 * h, qf);
    f32x16 O0, O1; zero16(O0); zero16(O1); float m = -1e30f, l = 0.f;
    const int ntile = (qb + 127) / 64 + 1;
    TileRegs tr;
    __syncthreads();
    tile_fetch(tr, tid, Kb, ZW, Vt, SEQ);
    u64 wn = maskT[0];
    tile_store(tr, tid, stg);
    __syncthreads();
    for (int j = 0; j < ntile; ++j) {
        const u64 w = wn;
        if (j + 1 < ntile) { tile_fetch(tr, tid, Kb + (size_t)((j + 1) * 64) * ZW, ZW, Vt + (j + 1) * 64, SEQ); wn = maskT[(size_t)(j + 1) * SEQ]; }
        if (__ballot(w != 0) != 0) {
            const u32 wl = (u32)(w >> (4 * h)), wh = (u32)(w >> (32 + 4 * h));
            flash_tile(lane, stg + (j & 1) * STAGE_U16, qf, O0, O1, m, l, [&](int kb, int c, float sv) { const u32 mk = (u32)__builtin_amdgcn_sbfe((int)(kb ? wh : wl), c, 1); return __uint_as_float((__float_as_uint(sv) & mk) | (0xff800000u & ~mk)); });
        }
        if (j + 1 < ntile) tile_store(tr, tid, stg + ((j + 1) & 1) * STAGE_U16);
        __syncthreads();
    }
    const float lt = l + __shfl_xor(l, 32);
    const float inv = lt > 0.f ? 1.f / lt : 0.f;
#pragma unroll
    for (int i = 0; i < 16; ++i) { O0[i] *= inv; O1[i] *= inv; }
    store_o((u16*)(p.ws + OFF_CONCAT) + (size_t)(b * SEQ + q0 + r31) * 1024 + hd * 64, O0, O1, h);
}

DI void item_nsa(const Params& p, int item, unsigned char* smem) {
    const int tid = otid(), lane = tid & 63, hd = tid >> 6, r31 = lane & 31, h = lane >> 5;
    const int b = item >> 7, q0 = (item & 127) * 32, t = q0 + r31;
    u16* stg = (u16*)smem;
    float* impP = (float*)smem;
    float* impS = (float*)(smem + 36864);
    u64* selm = (u64*)(smem + 36864 + 8448);
    u32* Uw = (u32*)(smem + 36864 + 8448 + 256);
    const u16* Z = (const u16*)(p.ws + OFF_Z) + (size_t)(b * SEQ) * ZW;
    bf16x8 qf[4]; load_q(Z + (size_t)t * ZW + ZC_DQ + hd * 64 + 8 * h, qf);
    float gt[3];
#pragma unroll
    for (int i = 0; i < 3; ++i) gt[i] = sigmoidf_(bf2f(Z[(size_t)t * ZW + ZC_DG + hd * 3 + i]));
    float* park = (float*)(p.ws + OFF_PARK) + (size_t)blockIdx.x * 32 * 256 + tid;
    f32x16 O0, O1; float m, l;
    TileRegs tr;
    const u16* KC = (const u16*)(p.ws + OFF_KCMP) + (size_t)b * 256 * 64;
    const u16* VC = (const u16*)(p.ws + OFF_VCMPT) + (size_t)b * 64 * 256;
    zero16(O0); zero16(O1); m = -1e30f; l = 0.f;
    const int ntc = min(4, q0 / 1024 + 1);
    const int nmax = (t >= 31) ? min(254, (t - 31) >> 4) : -1;
    const int nmax_lo = (q0 >= 31) ? min(254, (q0 - 31) >> 4) : -1;
    __syncthreads();
    if (tid < 2) Uw[tid] = 0;
    tile_fetch(tr, tid, KC, 64, VC, 256);
    tile_store(tr, tid, stg);
    __syncthreads();
    for (int T = 0; T < ntc; ++T) {
        if (T + 1 < ntc) tile_fetch(tr, tid, KC + (size_t)((T + 1) * 64) * 64, 64, VC + (T + 1) * 64, 256);
        const int lim = nmax - T * 64 - 4 * h;
        flash_tile(lane, stg + (T & 1) * STAGE_U16, qf, O0, O1, m, l, [&](int kb, int c, float sv) { return ((32 * kb + c) <= lim) ? sv : -INFINITY; });
        if (T + 1 < ntc) tile_store(tr, tid, stg + ((T + 1) & 1) * STAGE_U16);
        __syncthreads();
    }
    {
        const float lt = l + __shfl_xor(l, 32);
        const float inv = lt > 0.f ? 1.f / lt : 0.f;
#pragma unroll
        for (int i = 0; i < 16; ++i) { park[i * 256] = gt[0] * inv * O0[i]; park[(16 + i) * 256] = gt[0] * inv * O1[i]; }
        float prev_c = 0.f;
        for (int T = 0; T < 4; ++T) {
            f32x16 S0, S1; zero16(S0); zero16(S1);
            if (T < ntc) {
#pragma unroll
                for (int kk = 0; kk < 4; ++kk) {
                    const bf16x8 k0f = *(const bf16x8*)(KC + (size_t)(T * 64 + r31) * 64 + kk * 16 + 8 * h);
                    const bf16x8 k1f = *(const bf16x8*)(KC + (size_t)(T * 64 + 32 + r31) * 64 + kk * 16 + 8 * h);
                    S0 = MFMA32(k0f, qf[kk], S0); S1 = MFMA32(k1f, qf[kk], S1);
                }
            }
#pragma unroll
            for (int kb = 0; kb < 2; ++kb)
#pragma unroll
                for (int i = 0; i < 4; ++i) {
                    float pv[4];
#pragma unroll
                    for (int k = 0; k < 4; ++k) {
                        const int n = T * 64 + kb * 32 + 8 * i + 4 * h + k;
                        const float s = kb ? S1[4 * i + k] : S0[4 * i + k];
                        pv[k] = (T < ntc && n <= nmax) ? __builtin_amdgcn_exp2f(s - m) * inv : 0.f;
                    }
                    float a = pv[0] + pv[1] + pv[2] + 0.5f * pv[3];
                    const float c = 0.5f * pv[3];
                    const float recv = __shfl_xor(h ? prev_c : c, 32);
                    a += recv; prev_c = c;
                    impP[(hd * 32 + r31) * 64 + 16 * T + 8 * kb + 2 * i + h] = a;
                }
        }
    }
    __syncthreads();
    {
        const int q = tid >> 3, part = tid & 7, tq = q0 + q, curb = tq >> 6;
#pragma unroll
        for (int jj = 0; jj < 8; ++jj) {
            const int j = part * 8 + jj;
            float v = impP[(0 * 32 + q) * 64 + j] + impP[(1 * 32 + q) * 64 + j] + impP[(2 * 32 + q) * 64 + j] + impP[(3 * 32 + q) * 64 + j];
            if (j == curb || j == 0) v = INFINITY;
            if (64 * j > tq) v = -INFINITY;
            impS[q * 65 + j] = v;
        }
        __syncthreads();
        u32 bits = 0;
#pragma unroll
        for (int jj = 0; jj < 8; ++jj) {
            const int j = part * 8 + jj; const float v = impS[q * 65 + j];
            int rank = 0;
            for (int j2 = 0; j2 < 64; ++j2) { const float v2 = impS[q * 65 + j2]; rank += (v2 > v || (v2 == v && j2 < j)) ? 1 : 0; }
            if (rank < 16 && 64 * j <= tq) bits |= 1u << jj;
        }
        u64 w = (u64)bits << (8 * part);
        w |= sxq<1>(w); w |= sxq<2>(w); w |= sxq<4>(w);
        if (part == 0) { selm[q] = w; atomicOr(&Uw[0], (u32)w); atomicOr(&Uw[1], (u32)(w >> 32)); }
    }
    __syncthreads();
    const int cur = q0 >> 6;
    {
        const u64 sw = selm[r31];
        u64 U = (u64)Uw[0] | ((u64)Uw[1] << 32);
        const u16* Kb = Z + ZC_KS;
        const u16* Vt = (const u16*)(p.ws + OFF_VTS) + (size_t)b * 64 * SEQ;
        zero16(O0); zero16(O1); m = -1e30f; l = 0.f;
        int j = __builtin_ctzll(U); U &= U - 1;
        tile_fetch(tr, tid, Kb + (size_t)(j * 64) * ZW, ZW, Vt + j * 64, SEQ);
        tile_store(tr, tid, stg);
        __syncthreads();
        for (int i = 0;; ++i) {
            const int jn = U ? __builtin_ctzll(U) : -1; U &= U - 1;
            if (jn >= 0) tile_fetch(tr, tid, Kb + (size_t)(jn * 64) * ZW, ZW, Vt + jn * 64, SEQ);
            const bool bit = ((sw >> j) & 1ull) != 0;
            const int key0 = j * 64;
            const int lim = t - key0 - 4 * h;
            if (__ballot(bit) != 0) {
                if (j < cur) { const float rb = bit ? 0.f : -INFINITY; flash_tile(lane, stg + (i & 1) * STAGE_U16, qf, O0, O1, m, l, [&](int kb, int c, float sv) { return sv + rb; }); }
                else flash_tile(lane, stg + (i & 1) * STAGE_U16, qf, O0, O1, m, l, [&](int kb, int c, float sv) { return (bit && ((32 * kb + c) <= lim)) ? sv : -INFINITY; });
            }
            if (jn >= 0) tile_store(tr, tid, stg + ((i + 1) & 1) * STAGE_U16);
            __syncthreads();
            if (jn < 0) break;
            j = jn;
        }
        const float lt = l + __shfl_xor(l, 32);
        const float inv = lt > 0.f ? 1.f / lt : 0.f;
#pragma unroll
        for (int i = 0; i < 16; ++i) { park[i * 256] += gt[1] * inv * O0[i]; park[(16 + i) * 256] += gt[1] * inv * O1[i]; }
    }
    {
        const u16* Kb = Z + ZC_KW;
        const u16* Vt = (const u16*)(p.ws + OFF_VTW) + (size_t)b * 64 * SEQ;
        zero16(O0); zero16(O1); m = -1e30f; l = 0.f;
        const int j0 = max(0, q0 - 511) >> 6;
        tile_fetch(tr, tid, Kb + (size_t)(j0 * 64) * ZW, ZW, Vt + j0 * 64, SEQ);
        tile_store(tr, tid, stg);
        __syncthreads();
        for (int j = j0; j <= cur; ++j) {
            if (j < cur) tile_fetch(tr, tid, Kb + (size_t)((j + 1) * 64) * ZW, ZW, Vt + (j + 1) * 64, SEQ);
            const int key0 = j * 64;
            const int lhi = t - key0 - 4 * h, llo = lhi - 512;
            if (key0 + 63 <= q0 && key0 > q0 + 31 - 512) flash_tile(lane, stg + ((j - j0) & 1) * STAGE_U16, qf, O0, O1, m, l, [&](int kb, int c, float sv) { return sv; });
            else flash_tile(lane, stg + ((j - j0) & 1) * STAGE_U16, qf, O0, O1, m, l, [&](int kb, int c, float sv) { const int o = 32 * kb + c; return ((o <= lhi) && (o > llo)) ? sv : -INFINITY; });
            if (j < cur) tile_store(tr, tid, stg + ((j - j0 + 1) & 1) * STAGE_U16);
            __syncthreads();
        }
        const float lt = l + __shfl_xor(l, 32);
        const float inv = lt > 0.f ? 1.f / lt : 0.f;
#pragma unroll
        for (int i = 0; i < 16; ++i) { O0[i] = park[i * 256] + gt[2] * inv * O0[i]; O1[i] = park[(16 + i) * 256] + gt[2] * inv * O1[i]; }
    }
    store_o((u16*)(p.ws + OFF_CONCAT) + (size_t)(b * SEQ + t) * 1024 + 768 + hd * 64, O0, O1, h);
}

DI void phase_mix_b(const Params& p, int layer, unsigned char* smem) {
    int* ctr = (int*)(p.ws + OFF_CNT) + 64 + layer * 2 + 1;
    const int G = (int)gridDim.x;
    for (int first = 1;; first = 0) {
        const int it = first ? (int)blockIdx.x : G + next_item(ctr, smem);
        if (it >= 1024 + (layer == 0 ? WT_B : 0)) break;
        if (it >= 1024) {
            const int tidw = otid();
#pragma unroll 1
            for (int k = 0; k < 8; k += 4) wtile4(p, wt_tile_b((it - 1024) * 8 + k), wt_tile_b((it - 1024) * 8 + k + 1), wt_tile_b((it - 1024) * 8 + k + 2), wt_tile_b((it - 1024) * 8 + k + 3), smem, tidw);
            continue;
        }
        const int kind = it < 512 ? 1 : 0, r = it & 511;
        if (kind == 0) { const int b = r & 3, hd = (r >> 2) & 3, qt = 31 - (r >> 4); item_dsa_attn(p, (b << 7) | (hd << 5) | qt, smem); if (REP2 & 16) item_dsa_attn(p, (b << 7) | (hd << 5) | qt, smem); }
        else { const int b = r & 3, qt = 127 - (r >> 2);
#pragma unroll 1
            for (int rep = 0; rep < 1 + ((REP2 >> 5) & 1); ++rep) item_nsa(p, (b << 7) | qt, smem); }
    }
}

#define XB_TMO      128
#define XB_XCNT(j)  (256  + 64 * (j))
#define XB_XSUB(j)  (1280 + 64 * (j))
#define XB_XGEN(j)  (2304 + 64 * (j))
#define XB_TOP      3328
#define XB_TOPGEN   3392
#define XCD_BAR_WORDS 3456
#define XB_SPIN_CAP (1u << 23)
DI unsigned xb_ld(unsigned* p)              { return __hip_atomic_load(p, __ATOMIC_RELAXED, __HIP_MEMORY_SCOPE_AGENT); }
DI unsigned xb_add(unsigned* p, unsigned v) { return __hip_atomic_fetch_add(p, v, __ATOMIC_RELAXED, __HIP_MEMORY_SCOPE_AGENT); }
DI unsigned xb_xcc_id() { return (unsigned)__builtin_amdgcn_s_getreg((3 << 11) | 20) & 0xFu; }
#define XB_SPIN(cond, bar) do { unsigned _sp = 0; while (cond) { __builtin_amdgcn_s_sleep(1); \
    if ((++_sp & 255u) == 0u) { if (xb_ld(&(bar)[XB_TMO])) break; if (_sp > XB_SPIN_CAP) { atomicAdd(&(bar)[XB_TMO], 1u); break; } } } } while (0)
struct XcdBarrier { unsigned* bar; unsigned x; volatile LAS unsigned* st; };
DI XcdBarrier xcd_barrier_post(unsigned* bar, volatile LAS unsigned* st) {
    XcdBarrier b; b.bar = bar; b.x = xb_xcc_id(); b.st = st;
    if (threadIdx.x == 0) (void)xb_add(&bar[XB_XCNT(b.x)], 1u);
    return b;
}
DI void xcd_barrier_complete(unsigned* bar, unsigned x, unsigned& nloc, unsigned& nx) {
    const unsigned G = gridDim.x * gridDim.y * gridDim.z;
    unsigned sum, cnt, mine, sp = 0u;
    for (;;) {
        sum = 0u; cnt = 0u; mine = 0u;
#pragma unroll
        for (unsigned j = 0; j < 16; ++j) { const unsigned c = xb_ld(&bar[XB_XCNT(j)]); sum += c; cnt += (c > 0u) ? 1u : 0u; mine = (j == x) ? c : mine; }
        if (sum == G) break;
        __builtin_amdgcn_s_sleep(1);
        if ((++sp & 255u) == 0u) { if (xb_ld(&bar[XB_TMO])) break; if (sp > XB_SPIN_CAP) { atomicAdd(&bar[XB_TMO], 1u); break; } }
    }
    nloc = mine > 0u ? mine : 1u; nx = cnt > 0u ? cnt : 1u;
}
DI void xcd_barrier(const XcdBarrier& b) {
    asm volatile("s_waitcnt vmcnt(0)" ::: "memory");
    __syncthreads();
    if (threadIdx.x == 0) {
        unsigned* bar = b.bar;
        __builtin_amdgcn_s_waitcnt(0);
        unsigned nloc = b.st[0], nx = b.st[1];
        if (nloc == 0u) { xcd_barrier_complete(bar, b.x, nloc, nx); b.st[0] = nloc; b.st[1] = nx; }
        const unsigned old = xb_add(&bar[XB_XSUB(b.x)], 1u);
        const unsigned gen = old / nloc;
        if (old + 1u == (gen + 1u) * nloc) {
            __builtin_amdgcn_fence(__ATOMIC_RELEASE, "agent");
            asm volatile("s_waitcnt vmcnt(0)" ::: "memory");
            const unsigned og = xb_add(&bar[XB_TOP], 1u);
            const unsigned tg = og / nx;
            if (og + 1u == (tg + 1u) * nx) xb_add(&bar[XB_TOPGEN], 1u);
            else XB_SPIN(xb_ld(&bar[XB_TOPGEN]) == tg, bar);
            __builtin_amdgcn_fence(__ATOMIC_ACQUIRE, "agent");
            xb_add(&bar[XB_XGEN(b.x)], 1u);
            asm volatile("s_waitcnt vmcnt(0)" ::: "memory");
        } else {
            XB_SPIN(xb_ld(&bar[XB_XGEN(b.x)]) == gen, bar);
            __builtin_amdgcn_fence(__ATOMIC_ACQUIRE, "agent");
            asm volatile("s_waitcnt vmcnt(0)" ::: "memory");
        }
    }
    __syncthreads();
}

constexpr int NPHASE = 18;
__global__ void __launch_bounds__(256, 2) mega(Params p) {
    extern __shared__ __attribute__((aligned(16))) unsigned char smem[];
#if COOP
    if (threadIdx.x == 0) *(uint4*)(smem + SMEM_BYTES - 32) = make_uint4(0u, 0u, 0u, 0u);
    __syncthreads();
    const XcdBarrier xb = xcd_barrier_post((unsigned*)(p.ws + OFF_BAR), (volatile LAS unsigned*)(smem + SMEM_BYTES - 32));
    if (p.ph_hi > 1000000) cg::this_grid().sync();
#endif
#if COOP
#define GSYNC() xcd_barrier(xb)
#else
#define GSYNC()
#endif
#ifndef REPMASK
#define REPMASK 0
#endif
#define RUNPH(k, call) if (p.ph_lo <= (k) && (k) < p.ph_hi) { call; if ((k) + 1 < p.ph_hi) { GSYNC(); } }
#define RUNPHR(k, kind, call) if (p.ph_lo <= (k) && (k) < p.ph_hi) { call; if ((REPMASK >> (kind)) & 1) { GSYNC(); call; } if ((k) + 1 < p.ph_hi) { GSYNC(); } }
    RUNPHR(0, 0, phase0(p, smem))
#pragma unroll 1
    for (int layer = 0; layer < 2; ++layer) {
        const int pb = 1 + 8 * layer;
        RUNPHR(pb + 0, 1, phase_rownorm<0>(p, layer))
        RUNPHR(pb + 1, 2, phase_inproj(p, layer, smem))
        RUNPHR(pb + 2, 3, phase_mix_a(p, layer, smem))
        RUNPHR(pb + 3, 4, phase_mix_b(p, layer, smem))
        RUNPH(pb + 4, phase_outproj(p, layer, smem); if (((REPMASK >> 5) & 1) && layer == 0) { GSYNC(); phase_outproj(p, layer, smem); })
        RUNPH(pb + 5, phase_router<false>(p, layer, smem); if ((REPMASK >> 6) & 1) { GSYNC(); phase_router<true>(p, layer, smem); })
        RUNPHR(pb + 6, 7, phase_moe_gu(p, layer, smem))
        RUNPH(pb + 7, if ((REPMASK >> 8) & 1) { phase_moe_down<true>(p, layer, smem); GSYNC(); } phase_moe_down<false>(p, layer, smem))
    }
    RUNPH(NPHASE - 1, phase_rownorm<2>(p, 0))
#if TKCHECK
    GSYNC();
    if (blockIdx.x == 0 && threadIdx.x == 0) {
        const int bad = __hip_atomic_load((int*)(p.ws + OFF_CNT) + 100, __ATOMIC_RELAXED, __HIP_MEMORY_SCOPE_AGENT);
        const int hits = __hip_atomic_load((int*)(p.ws + OFF_CNT) + 101, __ATOMIC_RELAXED, __HIP_MEMORY_SCOPE_AGENT);
        if (bad) for (int i = 0; i < 65536; ++i) p.out[i] = 1000.f;
        else { const unsigned long long tw0 = wall_clock64(), dt = (unsigned long long)max(TKCHECK - hits, 0) * 1000ull;
            while (wall_clock64() - tw0 < dt) __builtin_amdgcn_s_sleep(8); }
    }
#endif
}

extern "C" void kernel_launch(void* const* d_in, const int* in_sizes, int n_in, void* d_out, int out_size, void* d_ws, size_t ws_size, hipStream_t stream) {
    static int grid = 0;
    if (grid == 0) {
        int dev = 0, cus = 0, per_cu = 0;
        hipGetDevice(&dev);
        hipDeviceGetAttribute(&cus, hipDeviceAttributeMultiprocessorCount, dev);
        hipFuncSetAttribute((const void*)mega, hipFuncAttributeMaxDynamicSharedMemorySize, SMEM_BYTES);
        hipOccupancyMaxActiveBlocksPerMultiprocessor(&per_cu, mega, 256, SMEM_BYTES);
        if (per_cu < 1) per_cu = 1;
        if (per_cu > 2) per_cu = 2;
        grid = cus * per_cu;
        if (ws_size < WS_END) { fprintf(stderr, "workspace too small: %zu < %zu\n", ws_size, (size_t)WS_END); grid = -1; }
    }
    if (grid < 0) return;
    Params p{};
    p.x = (const float*)d_in[0]; p.c = (const float*)d_in[1]; p.pos = (const int*)d_in[2];
    p.ada_w = (const float*)d_in[3]; p.ada_b = (const float*)d_in[4]; p.g_mix = (const float*)d_in[5]; p.g_ffn = (const float*)d_in[6];
    p.w_in = (const float*)d_in[7]; p.sgu_g = (const float*)d_in[8]; p.w_sgu = (const float*)d_in[9]; p.b_sgu = (const float*)d_in[10];
    p.w_pool = (const float*)d_in[11]; p.pool_scale = (const float*)d_in[12]; p.w_cmp1 = (const float*)d_in[13]; p.w_cmp2 = (const float*)d_in[14];
    p.cmp_pe = (const float*)d_in[15]; p.w_out = (const float*)d_in[16]; p.router_w = (const float*)d_in[17]; p.router_b = (const float*)d_in[18];
    p.w_gate = (const float*)d_in[19]; p.w_up = (const float*)d_in[20]; p.w_down = (const float*)d_in[21]; p.final_g = (const float*)d_in[22];
    p.out = (float*)d_out; p.ws = (unsigned char*)d_ws;
#if COOP
    hipMemsetAsync((char*)d_ws + OFF_BAR, 0, 16384, stream);
    p.ph_lo = 0; p.ph_hi = NPHASE;
    void* args[] = {&p};
    hipError_t e = hipLaunchCooperativeKernel((void*)mega, dim3(grid), dim3(256), args, SMEM_BYTES, stream);
    if (e != hipSuccess) fprintf(stderr, "cooperative launch failed: %s (grid %d)\n", hipGetErrorString(e), grid);
#else
    for (int ph = 0; ph < NPHASE; ++ph) {
        p.ph_lo = ph; p.ph_hi = ph + 1;
        hipLaunchKernelGGL(mega, dim3(grid), dim3(256), SMEM_BYTES, stream, p);
    }
#endif
}
```
